# Optimizing an MI355X kernel written in HIP

```python
import math
import jax, jax.numpy as jnp
from jax import lax
import numpy as np

D_MODEL = 4096
BATCH = 4
SEQ = 2048
DEPTH = 1
DEC_BATCH = 128
DEC_SEQ = 8
PAST_LEN = 16384
PAGE_SIZE = 128

POOL_WIDTH = D_MODEL // 4
POOL_WINDOWS = (2, 4, 8, 16)
POOL_GROUPS = len(POOL_WINDOWS)
POOL_GROUP_WIDTH = POOL_WIDTH // POOL_GROUPS
POOL_BUF = max(POOL_WINDOWS) - 1
DN_WIDTH = D_MODEL - POOL_WIDTH
DN_HEAD_DIM = 128
DN_HEADS = DN_WIDTH // DN_HEAD_DIM
CONV_WIDTH = 4
CONV_CH = 3 * DN_WIDTH
PROJ_OUT = POOL_WIDTH + 4 * DN_WIDTH + 2 * DN_HEADS
D_FF = -(-8 * D_MODEL // (3 * 256)) * 256
PLE_DIM = 256
CHUNK = 64
LN_EPS = 1e-5
RMS_EPS = 1e-6
L2_EPS = 1e-6
DN_ALPHA = (2.0 * DEPTH) ** 0.25
DN_BETA = (8.0 * DEPTH) ** -0.25

kernel_name = 'hymba_pool_gdn_deepnorm_step'


def _layer_norm(x, g, b):
    xf = x.astype(jnp.float32)
    mu = jnp.mean(xf, -1, keepdims=True)
    var = jnp.mean(jnp.square(xf - mu), -1, keepdims=True)
    y = (xf - mu) * lax.rsqrt(var + LN_EPS) * g.astype(jnp.float32) + b.astype(jnp.float32)
    return y.astype(x.dtype)


def _l2norm(x):
    return x * lax.rsqrt(jnp.sum(x * x, -1, keepdims=True) + L2_EPS)


def _pool_mixer(u, buf, start, w_pool, pool_scale):
    B, L, _ = u.shape
    ext = jnp.concatenate([buf.astype(u.dtype), u], axis=1)
    cs = jnp.cumsum(ext.astype(jnp.float32), axis=1)
    cs = jnp.concatenate([jnp.zeros((B, 1, POOL_WIDTH), jnp.float32), cs], axis=1)
    pos = start + jnp.arange(L)
    uf = u.astype(jnp.float32)
    outs = []
    for gi, w in enumerate(POOL_WINDOWS):
        lo, hi = gi * POOL_GROUP_WIDTH, (gi + 1) * POOL_GROUP_WIDTH
        s_end = cs[:, POOL_BUF + 1:, lo:hi]
        s_begin = cs[:, POOL_BUF + 1 - w:POOL_BUF + 1 - w + L, lo:hi]
        cnt = jnp.minimum(pos + 1, w).astype(jnp.float32)[None, :, None]
        outs.append((s_end - s_begin) / cnt - uf[..., lo:hi])
    d = jnp.stack(outs, axis=2).astype(u.dtype)
    y = jnp.einsum('blgc,gcd->blgd', d, w_pool).reshape(B, L, POOL_WIDTH) * pool_scale
    return y, ext[:, -POOL_BUF:]


def _short_conv(xc, buf, w_conv):
    L = xc.shape[1]
    ext = jnp.concatenate([buf.astype(xc.dtype), xc], axis=1)
    out = ext[:, 0:L] * w_conv[0]
    for j in range(1, CONV_WIDTH):
        out = out + ext[:, j:j + L] * w_conv[j]
    return jax.nn.silu(out), ext[:, -(CONV_WIDTH - 1):]


def _gated_delta(q, k, v, g, beta, s0):
    B, L, H, DK = q.shape
    DV = v.shape[-1]
    C = math.gcd(L, CHUNK)
    N = L // C

    def blk(t):
        return jnp.moveaxis(t.reshape((B, N, C, H) + t.shape[3:]), 3, 1)

    q, k, v, g, beta = blk(q), blk(k), blk(v), blk(g), blk(beta)
    gc = jnp.cumsum(g, axis=-1)
    incl = jnp.tril(jnp.ones((C, C), bool))
    strict = jnp.tril(jnp.ones((C, C), bool), -1)
    diff = gc[..., :, None] - gc[..., None, :]
    decay = jnp.where(incl, jnp.exp(jnp.where(incl, diff, 0.0)), 0.0)
    kb = k * beta[..., None]
    vb = v * beta[..., None]
    a_mat = jnp.where(strict, jnp.einsum('bhnik,bhnjk->bhnij', kb, k) * decay, 0.0)
    eye = jnp.eye(C, dtype=jnp.float32)
    t_mat = lax.linalg.triangular_solve(a_mat + eye, jnp.broadcast_to(eye, a_mat.shape),
                                        left_side=True, lower=True)
    u_intra = jnp.einsum('bhnij,bhnjv->bhniv', t_mat, vb)
    w_intra = jnp.einsum('bhnij,bhnjk->bhnik', t_mat, kb * jnp.exp(gc)[..., None])
    qk = jnp.where(incl, jnp.einsum('bhnik,bhnjk->bhnij', q, k) * decay, 0.0)

    def step(s, xs):
        qn, kn, un, wn, gn, qkn = xs
        v_new = un - jnp.einsum('bhck,bhkv->bhcv', wn, s)
        o = (jnp.einsum('bhck,bhkv->bhcv', qn * jnp.exp(gn)[..., None], s)
             + jnp.einsum('bhij,bhjv->bhiv', qkn, v_new))
        g_last = gn[..., -1:]
        s = s * jnp.exp(g_last)[..., None] + jnp.einsum(
            'bhck,bhcv->bhkv', kn * jnp.exp(g_last - gn)[..., None], v_new)
        return s, o

    xs = tuple(jnp.moveaxis(t, 2, 0) for t in (q, k, u_intra, w_intra, gc, qk))
    s_fin, o = lax.scan(step, s0, xs)
    o = jnp.transpose(o, (1, 0, 3, 2, 4)).reshape(B, L, H, DV)
    return o, s_fin


def _mixer(x, pool_buf, conv_buf, s0, start, w_in, w_pool, pool_scale, w_conv, a_log, dt_bias,
           o_norm_g, w_out):
    B, L, _ = x.shape
    f32 = jnp.float32
    proj = jnp.einsum('bld,de->ble', x, w_in)
    o1 = POOL_WIDTH
    o2 = o1 + CONV_CH
    o3 = o2 + DN_WIDTH
    o4 = o3 + DN_HEADS
    u = proj[..., :o1]
    qkv = proj[..., o1:o2]
    z = proj[..., o2:o3]
    b_raw = proj[..., o3:o4]
    a_raw = proj[..., o4:]
    y_pool, new_pool = _pool_mixer(u, pool_buf, start, w_pool, pool_scale)
    qkv, new_conv = _short_conv(qkv, conv_buf, w_conv)
    qkv = qkv.astype(f32).reshape(B, L, 3, DN_HEADS, DN_HEAD_DIM)
    q = _l2norm(qkv[:, :, 0]) * DN_HEAD_DIM ** -0.5
    k = _l2norm(qkv[:, :, 1])
    v = qkv[:, :, 2]
    beta = jax.nn.sigmoid(b_raw.astype(f32))
    g = -jnp.exp(a_log.astype(f32)) * jax.nn.softplus(a_raw.astype(f32) + dt_bias.astype(f32))
    o, s_new = _gated_delta(q, k, v, g, beta, s0.astype(f32))
    o = o * lax.rsqrt(jnp.mean(o * o, -1, keepdims=True) + RMS_EPS) * o_norm_g.astype(f32)
    o = o * jax.nn.silu(z.astype(f32)).reshape(B, L, DN_HEADS, DN_HEAD_DIM)
    o = o.reshape(B, L, DN_WIDTH).astype(x.dtype)
    mixed = jnp.concatenate([y_pool.astype(x.dtype), o], axis=-1)
    return jnp.einsum('bld,de->ble', mixed, w_out), new_pool, new_conv, s_new


def _layer(x, p, pool_buf, conv_buf, s0, start, lw):
    (w_in, w_pool, pool_scale, w_conv, a_log, dt_bias, o_norm_g, w_out,
     ln1_g, ln1_b, w_gate_up, w_down, ln2_g, ln2_b, w_ple_gate, w_ple_proj) = lw
    mix, new_pool, new_conv, s_new = _mixer(x, pool_buf, conv_buf, s0, start, w_in, w_pool,
                                            pool_scale, w_conv, a_log, dt_bias, o_norm_g, w_out)
    h = _layer_norm(DN_ALPHA * x + mix, ln1_g, ln1_b)
    gu = jnp.einsum('bld,df->blf', h, w_gate_up)
    ff = jnp.einsum('blf,fd->bld', jax.nn.silu(gu[..., :D_FF]) * gu[..., D_FF:], w_down)
    h = _layer_norm(DN_ALPHA * h + ff, ln2_g, ln2_b)
    gate = jax.nn.sigmoid(jnp.einsum('bld,de->ble', h, w_ple_gate).astype(jnp.float32))
    e = jnp.einsum('blp,pd->bld', p.astype(x.dtype), w_ple_proj).astype(jnp.float32)
    y = h + (gate * e).astype(h.dtype)
    return y, new_pool, new_conv, s_new


def setup_inputs(seed: int = 0) -> dict:
    key = jax.random.key(seed)
    ks = jax.random.split(key, 24)
    f32 = jnp.float32

    def nrm(k, shape, s):
        return jax.random.normal(k, shape, f32) * s

    G = POOL_GROUP_WIDTH
    x_prompt = nrm(ks[0], (BATCH, SEQ, D_MODEL), 1.0)
    x_sample = nrm(ks[1], (DEC_BATCH, DEC_SEQ, D_MODEL), 1.0)
    state_pool = nrm(ks[2], (DEPTH, DEC_BATCH, POOL_BUF, POOL_WIDTH), 1.0)
    state_conv = nrm(ks[3], (DEPTH, DEC_BATCH, CONV_WIDTH - 1, CONV_CH), 1.0)
    state_delta = nrm(ks[4], (DEPTH, DEC_BATCH, DN_HEADS, DN_HEAD_DIM, DN_HEAD_DIM), 0.05)
    p_prompt = nrm(ks[5], (DEPTH, BATCH, SEQ, PLE_DIM), 1.0)
    p_sample = nrm(ks[6], (DEPTH, DEC_BATCH, DEC_SEQ, PLE_DIM), 1.0)
    w_in = nrm(ks[7], (DEPTH, D_MODEL, PROJ_OUT), D_MODEL ** -0.5)
    w_pool = nrm(ks[8], (DEPTH, POOL_GROUPS, G, G), G ** -0.5)
    pool_scale = 1.0 + nrm(ks[9], (DEPTH, POOL_WIDTH), 0.1)
    w_conv = nrm(ks[10], (DEPTH, CONV_WIDTH, CONV_CH), CONV_WIDTH ** -0.5)
    a_log = jnp.log(jax.random.uniform(ks[11], (DEPTH, DN_HEADS), f32, 1.0, 16.0))
    dt = jnp.exp(jax.random.uniform(ks[12], (DEPTH, DN_HEADS), f32, math.log(1e-3), math.log(1e-1)))
    dt_bias = dt + jnp.log(-jnp.expm1(-dt))
    o_norm_g = 1.0 + nrm(ks[13], (DEPTH, DN_HEAD_DIM), 0.1)
    w_out = nrm(ks[14], (DEPTH, D_MODEL, D_MODEL), D_MODEL ** -0.5 * DN_BETA)
    ln1_g = 1.0 + nrm(ks[15], (DEPTH, D_MODEL), 0.1)
    ln1_b = nrm(ks[16], (DEPTH, D_MODEL), 0.02)
    w_gate_up = nrm(ks[17], (DEPTH, D_MODEL, 2 * D_FF), D_MODEL ** -0.5)
    w_down = nrm(ks[18], (DEPTH, D_FF, D_MODEL), D_FF ** -0.5 * DN_BETA)
    ln2_g = 1.0 + nrm(ks[19], (DEPTH, D_MODEL), 0.1)
    ln2_b = nrm(ks[20], (DEPTH, D_MODEL), 0.02)
    w_ple_gate = nrm(ks[21], (DEPTH, D_MODEL, D_MODEL), D_MODEL ** -0.5)
    w_ple_proj = nrm(ks[22], (DEPTH, PLE_DIM, D_MODEL), PLE_DIM ** -0.5 * 0.5)
    return {'x_prompt': x_prompt, 'x_sample': x_sample, 'state_pool': state_pool,
            'state_conv': state_conv, 'state_delta': state_delta, 'p_prompt': p_prompt,
            'p_sample': p_sample, 'w_in': w_in, 'w_pool': w_pool, 'pool_scale': pool_scale,
            'w_conv': w_conv, 'a_log': a_log, 'dt_bias': dt_bias, 'o_norm_g': o_norm_g,
            'w_out': w_out, 'ln1_g': ln1_g, 'ln1_b': ln1_b, 'w_gate_up': w_gate_up,
            'w_down': w_down, 'ln2_g': ln2_g, 'ln2_b': ln2_b, 'w_ple_gate': w_ple_gate,
            'w_ple_proj': w_ple_proj}


def reference(x_prompt, x_sample, state_pool, state_conv, state_delta, p_prompt, p_sample,
              w_in, w_pool, pool_scale, w_conv, a_log, dt_bias, o_norm_g, w_out,
              ln1_g, ln1_b, w_gate_up, w_down, ln2_g, ln2_b, w_ple_gate, w_ple_proj):
    B = x_prompt.shape[0]
    yp, ys = x_prompt, x_sample
    pool_p, conv_p, delta_p, pool_s, conv_s, delta_s = [], [], [], [], [], []
    for i in range(DEPTH):
        lw = (w_in[i], w_pool[i], pool_scale[i], w_conv[i], a_log[i], dt_bias[i], o_norm_g[i],
              w_out[i], ln1_g[i], ln1_b[i], w_gate_up[i], w_down[i], ln2_g[i], ln2_b[i],
              w_ple_gate[i], w_ple_proj[i])
        pool0 = jnp.zeros((B, POOL_BUF, POOL_WIDTH), x_prompt.dtype)
        conv0 = jnp.zeros((B, CONV_WIDTH - 1, CONV_CH), x_prompt.dtype)
        s0 = jnp.zeros((B, DN_HEADS, DN_HEAD_DIM, DN_HEAD_DIM), jnp.float32)
        yp, npl, ncv, nst = _layer(yp, p_prompt[i], pool0, conv0, s0, 0, lw)
        ys, spl, scv, sst = _layer(ys, p_sample[i], state_pool[i], state_conv[i], state_delta[i],
                                   PAST_LEN, lw)
        pool_p.append(npl)
        conv_p.append(ncv)
        delta_p.append(nst)
        pool_s.append(spl)
        conv_s.append(scv)
        delta_s.append(sst)
    return (yp, ys, jnp.stack(pool_p), jnp.stack(conv_p), jnp.stack(delta_p),
            jnp.stack(pool_s), jnp.stack(conv_s), jnp.stack(delta_s))
```

```cpp
#include <hip/hip_runtime.h>
#include <cstdio>
#include <cstdint>

#define GAS __attribute__((address_space(1)))
#define LAS __attribute__((address_space(3)))
typedef unsigned short bf16_t;
typedef short bf16x8 __attribute__((ext_vector_type(8)));
typedef float f32x4 __attribute__((ext_vector_type(4)));
typedef float f32x2 __attribute__((ext_vector_type(2)));
typedef unsigned u32x4 __attribute__((ext_vector_type(4)));
typedef unsigned u32x2 __attribute__((ext_vector_type(2)));

constexpr int DM = 4096, NB = 4, SEQ = 2048, DB = 128, DS = 8;
constexpr int MP = NB * SEQ, MS = DB * DS, M = MP + MS;
constexpr int PW = 1024, DNW = 3072, HD = 128, NH = 24, CCH = 9216;
constexpr int PROJ_OUT = 13360, PROJ_PAD = 13568, PROJ_LD = 13312;
constexpr int DFF = 11008, PLE = 256;
constexpr float LN_EPS = 1e-5f, RMS_EPS = 1e-6f, L2_EPS = 1e-6f;
constexpr float DN_ALPHA = 1.189207115002721f;
constexpr int O1 = PW, O2 = O1 + CCH, O3 = O2 + DNW;

constexpr size_t OUT_Y = 0;
constexpr size_t OUT_NPP = (size_t)M * DM;
constexpr size_t OUT_NCP = OUT_NPP + (size_t)NB * 15 * PW;
constexpr size_t OUT_NDP = OUT_NCP + (size_t)NB * 3 * CCH;
constexpr size_t OUT_NPS = OUT_NDP + (size_t)NB * NH * HD * HD;
constexpr size_t OUT_NCS = OUT_NPS + (size_t)DB * 15 * PW;
constexpr size_t OUT_NDS = OUT_NCS + (size_t)DB * 3 * CCH;
constexpr size_t OUT_END = OUT_NDS + (size_t)DB * NH * HD * HD;

constexpr size_t MiB = 1u << 20;
constexpr size_t WS_CTL = 0, CTL_ZERO_BYTES = 1 * MiB;
constexpr size_t WS_WIN = 1 * MiB;
constexpr size_t WS_XB = 107 * MiB;
constexpr size_t WS_WOUT = 179 * MiB;
constexpr size_t WS_WGU = 211 * MiB;
constexpr size_t WS_WDN = 383 * MiB;
constexpr size_t WS_WPG = 469 * MiB;
constexpr size_t WS_WPP = 501 * MiB;
constexpr size_t WS_WPOOL = 503 * MiB;
constexpr size_t WS_PB = 504 * MiB;
constexpr size_t WS_PROJ = 509 * MiB;
constexpr size_t WS_BA = 743 * MiB;
constexpr size_t WS_DPOOL = 746 * MiB;
constexpr size_t WS_MIXED = 764 * MiB;
constexpr size_t WS_G1 = 836 * MiB;
constexpr size_t WS_GLAST = 1100 * MiB;
constexpr size_t WS_GA = 1101 * MiB;
constexpr size_t WS_GB = 1102 * MiB;
constexpr size_t WS_GL = 1103 * MiB;
constexpr size_t WS_O = 1104 * MiB;
constexpr size_t WS_CPART = 1212 * MiB;
constexpr size_t WS_PST = 1226 * MiB;
constexpr size_t WS_END = 1232 * MiB;
constexpr int CP_N = 2 * DFF + DM;
constexpr size_t WS_QN = WS_WIN, WS_KN = WS_WIN + 54 * MiB, WS_VC = WS_WIN + 108 * MiB;
constexpr size_t WS_ACT = WS_PROJ, WS_H = WS_G1, WS_HB = WS_G1 + 144 * MiB, WS_E = WS_O, WS_H2B = WS_XB;
constexpr size_t WS_H2B8 = WS_WIN + 65 * MiB;
constexpr float W8_SCALE = 64.f, W8_INV = 1.f / 64.f;
constexpr float A8I_INV = 127.f / 8.f, W8I_INV = 127.f * 64.f / 6.f, GU8I_SCALE = (8.f / 127.f) * (6.f / (127.f * 64.f));
constexpr int WDN8_SCALE = 128; constexpr float ACT8_SCALE = 8.f, DN8_INV = 1.f / (128.f * 8.f);
constexpr size_t WS_SLAB = WS_WIN;
constexpr int G1_CHUNK_BYTES = 71680;
constexpr int G1_WF = 0, G1_QGF = 16384, G1_QKF = 32768, G1_KDF = 38912, G1_UF = 55296;
constexpr int CW_BAR = 4096;
constexpr int CW_ROWS1 = 9216, CW_ROWS2 = 9280;
constexpr size_t CTL_ST1 = 65536, CTL_ST2 = 139264, CTL_C1GU = 262144, CTL_C2GU = 350208, CTL_C1PG = 438272, CTL_C2PG = 454656;

constexpr int RING_BYTES = 160768;
constexpr int LDSCTL_OFF = RING_BYTES, MISC_OFF = LDSCTL_OFF + 320;
constexpr int LDS_BYTES = 161792;
constexpr int NWAVES = 8;

#define LDS_WAIT() asm volatile("s_waitcnt lgkmcnt(0)" ::: "memory")
#define VM_WAIT() asm volatile("s_waitcnt vmcnt(0)" ::: "memory")

__device__ __forceinline__ unsigned f2bf(float f) { unsigned u = __builtin_bit_cast(unsigned, f); return (u + 0x7fffu + ((u >> 16) & 1u)) >> 16; }
__device__ __forceinline__ unsigned pk2(float lo, float hi) { return f2bf(lo) | (f2bf(hi) << 16); }
__device__ __forceinline__ float bf_lo(unsigned w) { return __builtin_bit_cast(float, w << 16); }
__device__ __forceinline__ float bf_hi(unsigned w) { return __builtin_bit_cast(float, w & 0xffff0000u); }
__device__ __forceinline__ int lane_id() { int l; asm volatile("v_mbcnt_lo_u32_b32 %0, -1, 0\n\tv_mbcnt_hi_u32_b32 %0, -1, %0" : "=v"(l)); return l; }
__device__ __forceinline__ float fast_sigmoid(float x) { return __builtin_amdgcn_rcpf(1.f + __builtin_amdgcn_exp2f(-1.4426950408889634f * x)); }

template <int X> __device__ __forceinline__ float swz_xor(float v) { return __builtin_bit_cast(float, __builtin_amdgcn_ds_swizzle(__builtin_bit_cast(int, v), (X << 10) | 0x1f)); }
__device__ __forceinline__ float sum16(float v) { v += swz_xor<1>(v); v += swz_xor<2>(v); v += swz_xor<4>(v); v += swz_xor<8>(v); return v; }
__device__ __forceinline__ float wave_sum(float v) {
    v = sum16(v); v += swz_xor<16>(v);
    return __builtin_bit_cast(float, __builtin_amdgcn_readlane(__builtin_bit_cast(int, v), 0)) + __builtin_bit_cast(float, __builtin_amdgcn_readlane(__builtin_bit_cast(int, v), 32));
}

__device__ __forceinline__ float bperm_f(int src_lane, float v) { return __builtin_bit_cast(float, __builtin_amdgcn_ds_bpermute(src_lane << 2, __builtin_bit_cast(int, v))); }

namespace pg8 {
constexpr int BM = 256, BK = 64, HALF = 128, HTB = HALF * BK * 2, STAGE_BYTES = 8 * HTB, NXCD = 8, WGM = 8;
__host__ __device__ __forceinline__ int lds_byte(int r, int c) { const int st = (r >> 4) * 2 + (c >> 5), rr = r & 15, cc = c & 31, ob = rr * 64 + cc * 2; return st * 1024 + (ob ^ (((ob >> 9) & 1) << 5)); }
__host__ __device__ __forceinline__ void stage_rc(int b, int& R, int& C) { const int st = b / 1024, sb = b % 1024, swz = sb ^ (((sb >> 9) & 1) << 5); R = (st >> 1) * 16 + swz / 64; C = (st & 1) * 32 + (swz % 64) / 2; }
__host__ __device__ __forceinline__ int perm32(int rho) { const int n = rho >> 4, i = rho & 15; return 8 * (i >> 2) + 4 * n + (i & 3); }

struct Unit { int pm, pn, k0, nk, split, aux; };
typedef int v8i_t __attribute__((ext_vector_type(8)));
typedef int v4i_t __attribute__((ext_vector_type(4)));
__device__ __forceinline__ v8i_t cat8(bf16x8 a, bf16x8 b) { const v4i_t x = __builtin_bit_cast(v4i_t, a), y = __builtin_bit_cast(v4i_t, b); return __builtin_shufflevector(x, y, 0, 1, 2, 3, 4, 5, 6, 7); }
__device__ __forceinline__ unsigned pk4_fp8(float a, float b, float c, float d) { int w = 0; w = __builtin_amdgcn_cvt_pk_fp8_f32(a, b, w, false); w = __builtin_amdgcn_cvt_pk_fp8_f32(c, d, w, true); return (unsigned)w; }
__device__ __forceinline__ void st_wt8x(void* p, u32x2 v) { asm volatile("global_store_dwordx2 %0, %1, off sc1\n\ts_nop 1" :: "v"(p), "v"(v) : "memory"); }
typedef int i32x4_t __attribute__((ext_vector_type(4)));
__device__ __forceinline__ unsigned pk4_i8(float a, float b, float c, float d) {
    const int ia = (int)__builtin_rintf(__builtin_fminf(__builtin_fmaxf(a, -127.f), 127.f)), ib = (int)__builtin_rintf(__builtin_fminf(__builtin_fmaxf(b, -127.f), 127.f));
    const int ic = (int)__builtin_rintf(__builtin_fminf(__builtin_fmaxf(c, -127.f), 127.f)), id = (int)__builtin_rintf(__builtin_fminf(__builtin_fmaxf(d, -127.f), 127.f));
    return (unsigned)(ia & 255) | ((unsigned)(ib & 255) << 8) | ((unsigned)(ic & 255) << 16) | ((unsigned)id << 24);
}
struct Gemm { const bf16_t* A; const bf16_t* Bt; int M, N, K, lda, ldb, acol; const unsigned* wait_cnt = nullptr; unsigned wait_n = 0; bool epi_wait = false; };

struct StaticOrder {
    int nM, nN, nwg, G, c, nk_all;
    __device__ void init(int M_, int N_, int K_, int G_, int c_) { nM = M_ / BM; nN = N_ / BM; nwg = nM * nN; G = G_; c = c_; nk_all = K_ / BK; }
    __device__ bool next(int i, Unit& u) const { return map((long)i * G + c, u); }
    __device__ bool map(long L, Unit& u) const {
        if (L >= nwg) return false;
        int wgid = (int)L; { const int q = nwg / NXCD, r = nwg % NXCD, xcd = wgid % NXCD, off = wgid / NXCD; wgid = (xcd < r ? xcd * (q + 1) : r * (q + 1) + (xcd - r) * q) + off; }
        const int nig = WGM * nN, gid = wgid / nig, fm = gid * WGM, gsz = (nM - fm) < WGM ? (nM - fm) : WGM;
        u.pm = fm + ((wgid % nig) % gsz); u.pn = (wgid % nig) / gsz; u.k0 = 0; u.nk = nk_all; u.split = -1; u.aux = 0; return true;
    }
};
constexpr int GU_LEFT = 24, GU_LEFT_PN0 = 86 - GU_LEFT;
struct GUOrder {
    StaticOrder sp; int G, c;
    __device__ void init(int G_, int c_, int K_ = DM) { sp.init(8192, 2 * DFF, K_, G_, c_); G = G_; c = c_; }
    __device__ bool next(int i, Unit& u) const {
        if (G != 256) return false;
        if (i < 12) { const int L = i * 256 + c; if (L < 32 * 86) return sp.map(L, u);
            const int sidx = L - 32 * 86; u.pm = 32 + sidx / 86; u.pn = sidx % 86; u.k0 = 0; u.nk = sp.nk_all; u.split = -1; u.aux = 0; return true; }
        if (i > 12 || c >= GU_LEFT * 8) return false;
        const int ul = c % GU_LEFT, sl = c / GU_LEFT; u.pm = 35; u.pn = GU_LEFT_PN0 + ul; u.k0 = (sp.nk_all / 8) * sl; u.nk = sp.nk_all / 8; u.split = sl; u.aux = ul; return true;
    }
};
struct SplitOrder {
    StaticOrder so; int q, r2;
    __device__ void init(int N_, int K_, int G_, int c_) { so.init(8192, N_, K_, G_, c_); const int nt = K_ / BK; q = (nt / 4) & ~1; r2 = (nt - 4 * q) / 2; }
    __device__ bool next(int i, Unit& u) const {
        if (i < 2) return so.next(i, u);
        if (i > 2 || so.G != 256) return false;
        const int c = so.c, sl = c & 3, tl = (c >> 3) + 32 * ((c >> 2) & 1);
        u.pm = 32 + (tl >> 4); u.pn = tl & 15; u.k0 = sl * q + 2 * (sl < r2 ? sl : r2); u.nk = q + (sl < r2 ? 2 : 0); u.split = sl; u.aux = 0; return true;
    }
};

__device__ __forceinline__ unsigned cvt_pk_bf16(float lo, float hi) { unsigned r; asm volatile("v_cvt_pk_bf16_f32 %0, %1, %2" : "=v"(r) : "v"(lo), "v"(hi)); return r; }

template <class Epi, class Order = StaticOrder, bool ALIGN_EPI = true, int QM = 0>
__device__ __forceinline__ void gemm_phase(LAS unsigned char* lds, const Gemm g, const Order& S, const Epi& E, const int wid) {
    int lane_ = lane_id(); asm volatile("" : "+v"(lane_));
    const int lane = lane_, tid = wid * 64 + lane, wr = wid >> 2, wc = wid & 3, fr = lane & 15, fq = lane >> 4;
    unsigned voffA[2], voffB[2];
#pragma unroll
    for (int i = 0; i < 2; ++i) { int R, C; stage_rc(tid * 16 + i * 8192, R, C); const int Rb = Epi::PERM ? ((R & ~31) + perm32(R & 31)) : R;
        voffA[i] = (unsigned)(R * g.lda + C) * 2u; voffB[i] = (unsigned)(Rb * g.ldb + C) * 2u; }
    const size_t kstep = (size_t)(BK * 2);
    const size_t hstepA = (size_t)HALF * g.lda * 2, hstepB = (size_t)HALF * g.ldb * 2;
    const size_t tstepA = 2 * hstepA, tstepB = 2 * hstepB, cstepA = (size_t)g.acol * 2;
    const unsigned ldsw = (unsigned)wid * 1024u;
    const int aoff = lds_byte(wr * 64 + fr, fq * 8), boff = lds_byte(wc * 32 + fr, fq * 8);
#define PG8_SA(b, h) (((b) * 2 + (h)) * HTB)
#define PG8_SB(b, h) ((4 + (b) * 2 + (h)) * HTB)
#define PG8_STAGE(bufoff, gbase, voff) do { _Pragma("unroll") for (int _i = 0; _i < 2; ++_i) \
        __builtin_amdgcn_global_load_lds((const unsigned*)((const char*)(gbase) + (voff)[_i]), (LAS unsigned*)(lds + (bufoff) + ldsw + _i * 8192), 16, 0, 0); } while (0)
#define PG8_LDA(dst, b, h) do { _Pragma("unroll") for (int m = 0; m < 4; ++m) _Pragma("unroll") for (int k = 0; k < 2; ++k) dst[m][k] = *(const LAS bf16x8*)(lds + PG8_SA(b, h) + aoff + m * 2048 + k * 1024); } while (0)
#define PG8_LDB(dst, b, h) do { _Pragma("unroll") for (int n = 0; n < 2; ++n) _Pragma("unroll") for (int k = 0; k < 2; ++k) dst[n][k] = *(const LAS bf16x8*)(lds + PG8_SB(b, h) + boff + n * 2048 + k * 1024); } while (0)
#define PG8_MMA(ai, bj, At, Bt) do { __builtin_amdgcn_s_setprio(1); if constexpr (QM == 2) { _Pragma("unroll") for (int m = 0; m < 4; ++m) _Pragma("unroll") for (int n = 0; n < 2; ++n) _Pragma("unroll") for (int k = 0; k < 2; ++k) \
        acc[ai][bj][m][n] = __builtin_bit_cast(f32x4, __builtin_amdgcn_mfma_i32_16x16x64_i8(__builtin_bit_cast(i32x4_t, Bt[n][k]), __builtin_bit_cast(i32x4_t, At[m][k]), __builtin_bit_cast(i32x4_t, acc[ai][bj][m][n]), 0, 0, 0)); } else if constexpr (QM == 1) { _Pragma("unroll") for (int m = 0; m < 4; ++m) _Pragma("unroll") for (int n = 0; n < 2; ++n) \
        asm volatile("v_mfma_f32_16x16x128_f8f6f4 %0, %1, %2, %0" : "+v"(acc[ai][bj][m][n]) : "v"(cat8(Bt[n][0], Bt[n][1])), "v"(cat8(At[m][0], At[m][1]))); } else { \
        _Pragma("unroll") for (int m = 0; m < 4; ++m) _Pragma("unroll") for (int n = 0; n < 2; ++n) _Pragma("unroll") for (int k = 0; k < 2; ++k) \
        acc[ai][bj][m][n] = __builtin_amdgcn_mfma_f32_16x16x32_bf16(Bt[n][k], At[m][k], acc[ai][bj][m][n], 0, 0, 0); } __builtin_amdgcn_s_setprio(0); } while (0)
#define PG8_WAIT_V(n) asm volatile("s_waitcnt vmcnt(" #n ")" ::: "memory")
#define PG8_WAIT_L(n) asm volatile("s_waitcnt lgkmcnt(" #n ")" ::: "memory")
#define PG8_BAR __builtin_amdgcn_s_barrier()
#define PG8_SCHED __builtin_amdgcn_sched_barrier(0)
    Unit cur, nxt; int ui = 0; bool waited = false, ewaited = false;
    if (!S.next(0, cur)) return;
    f32x4 acc[2][2][4][2];
#pragma unroll
    for (int a = 0; a < 2; ++a)
#pragma unroll
        for (int b = 0; b < 2; ++b)
#pragma unroll
            for (int m = 0; m < 4; ++m)
#pragma unroll
                for (int n = 0; n < 2; ++n) acc[a][b][m][n] = (f32x4){0.f, 0.f, 0.f, 0.f};
    bf16x8 At[4][2], B0[2][2], B1[2][2];
    const char* cA = (const char*)g.A + (size_t)cur.pm * tstepA + (size_t)cur.pn * cstepA + (size_t)cur.k0 * kstep; const char* cB = (const char*)g.Bt + (size_t)cur.pn * tstepB + (size_t)cur.k0 * kstep;
    PG8_STAGE(PG8_SB(0, 0), cB, voffB); PG8_STAGE(PG8_SB(0, 1), cB + hstepB, voffB); PG8_STAGE(PG8_SA(0, 0), cA, voffA); PG8_STAGE(PG8_SA(0, 1), cA + hstepA, voffA);
    if (wr == 1) PG8_BAR;
    PG8_WAIT_V(2); PG8_BAR;
    PG8_STAGE(PG8_SB(1, 0), cB + kstep, voffB); PG8_STAGE(PG8_SA(1, 0), cA + kstep, voffA); PG8_STAGE(PG8_SB(1, 1), cB + hstepB + kstep, voffB);
    PG8_WAIT_V(6); PG8_BAR;
    for (;;) {
        const bool has_next = S.next(ui + 1, nxt);
        const char* nA = has_next ? (const char*)g.A + (size_t)nxt.pm * tstepA + (size_t)nxt.pn * cstepA + (size_t)nxt.k0 * kstep : cA; const char* nB = has_next ? (const char*)g.Bt + (size_t)nxt.pn * tstepB + (size_t)nxt.k0 * kstep : cB;
        const int nt = cur.nk;
        if (g.wait_cnt && has_next && nxt.pm >= 32 && !waited) { waited = true;
            unsigned sp_ = 0; while (__hip_atomic_load(g.wait_cnt, __ATOMIC_RELAXED, __HIP_MEMORY_SCOPE_AGENT) < g.wait_n && ++sp_ < (1u << 22)) __builtin_amdgcn_s_sleep(4);
            __builtin_amdgcn_fence(__ATOMIC_ACQUIRE, "agent"); asm volatile("s_waitcnt vmcnt(0)" ::: "memory"); }
        for (int t = 0; t < nt; t += 2) {
            const bool last = (t == nt - 2);
            const char* a1 = cA + (size_t)(t + 1) * kstep;
            const char* a2 = last ? nA : cA + (size_t)(t + 2) * kstep; const char* b2 = last ? nB : cB + (size_t)(t + 2) * kstep;
            const char* a3 = a2 + kstep; const char* b3 = b2 + kstep;
            PG8_LDB(B0, 0, 0); PG8_LDB(B1, 0, 1); PG8_SCHED; PG8_LDA(At, 0, 0); PG8_STAGE(PG8_SA(1, 1), a1 + hstepA, voffA);
            PG8_WAIT_V(8); PG8_WAIT_L(0); PG8_BAR; PG8_MMA(0, 0, At, B0); PG8_MMA(0, 1, At, B1); PG8_BAR; PG8_SCHED;
            PG8_LDA(At, 0, 1); PG8_STAGE(PG8_SB(0, 0), b2, voffB); PG8_STAGE(PG8_SB(0, 1), b2 + hstepB, voffB); PG8_STAGE(PG8_SA(0, 0), a2, voffA);
            PG8_WAIT_V(8); PG8_WAIT_L(0); PG8_BAR; PG8_MMA(1, 0, At, B0); PG8_MMA(1, 1, At, B1); PG8_BAR; PG8_SCHED;
            PG8_LDB(B0, 1, 0); PG8_LDB(B1, 1, 1); PG8_SCHED; PG8_LDA(At, 1, 0); PG8_STAGE(PG8_SA(0, 1), a2 + hstepA, voffA);
            PG8_WAIT_V(8); PG8_WAIT_L(0); PG8_BAR; PG8_MMA(0, 0, At, B0); PG8_MMA(0, 1, At, B1); PG8_BAR; PG8_SCHED;
            PG8_LDA(At, 1, 1); PG8_STAGE(PG8_SB(1, 0), b3, voffB); PG8_STAGE(PG8_SB(1, 1), b3 + hstepB, voffB); PG8_STAGE(PG8_SA(1, 0), a3, voffA);
            PG8_WAIT_V(8); PG8_WAIT_L(0); PG8_BAR; PG8_MMA(1, 0, At, B0); PG8_MMA(1, 1, At, B1); PG8_BAR; PG8_SCHED;
        }
        if constexpr (QM == 1) { asm volatile("s_nop 15\n\ts_nop 15" ::: "memory"); }
        if (g.epi_wait && !ewaited) { ewaited = true;
            unsigned sp_ = 0; while (__hip_atomic_load(g.wait_cnt, __ATOMIC_RELAXED, __HIP_MEMORY_SCOPE_AGENT) < g.wait_n && ++sp_ < (1u << 22)) __builtin_amdgcn_s_sleep(4);
            __builtin_amdgcn_fence(__ATOMIC_ACQUIRE, "agent"); asm volatile("s_waitcnt vmcnt(0)" ::: "memory"); }
        if constexpr (ALIGN_EPI) { if (wr == 0) PG8_BAR; }
        E(acc, cur, wr, wc, fr, fq);
        if (!has_next) break;
#pragma unroll
        for (int a = 0; a < 2; ++a)
#pragma unroll
            for (int b = 0; b < 2; ++b)
#pragma unroll
                for (int m = 0; m < 4; ++m)
#pragma unroll
                    for (int n = 0; n < 2; ++n) acc[a][b][m][n] = (f32x4){0.f, 0.f, 0.f, 0.f};
        cur = nxt; cA = nA; cB = nB; ++ui;
        if constexpr (ALIGN_EPI) { if (wr == 1) PG8_BAR; }
    }
    PG8_WAIT_V(0);
    if constexpr (!ALIGN_EPI) { if (wr == 0) PG8_BAR; }
    PG8_BAR;
#undef PG8_SA
#undef PG8_SB
#undef PG8_STAGE
#undef PG8_LDA
#undef PG8_LDB
#undef PG8_MMA
#undef PG8_WAIT_V
#undef PG8_WAIT_L
#undef PG8_BAR
#undef PG8_SCHED
}

typedef const f32x4 (&AccRef)[2][2][4][2];
struct f32x4_acc_t { f32x4 v[2][2][4][2]; };

struct EpiProj {
    static constexpr bool PERM = true;
    bf16_t* P; float* BA; float* out;
    __device__ __forceinline__ void operator()(AccRef acc, const Unit& u, int wr, int wc, int fr, int fq) const {
        const int row0 = u.pm * BM + wr * 64 + fr, colw = wc * 32 + 8 * fq;
        const bool sample = u.pm >= 32; const bool tailp = (u.pm & 7) == 7;
#pragma unroll
        for (int ai = 0; ai < 2; ++ai)
#pragma unroll
            for (int m = 0; m < 4; ++m) {
                const int row = row0 + ai * HALF + m * 16;
#pragma unroll
                for (int bj = 0; bj < 2; ++bj) {
                    const f32x4 v0 = acc[ai][bj][m][0], v1 = acc[ai][bj][m][1];
                    const int colt = bj * HALF + colw;
                    const int col = u.pn * BM + colt;
                    if (u.pn < 52) {
                        u32x4 w; w.x = cvt_pk_bf16(v0[0], v0[1]); w.y = cvt_pk_bf16(v0[2], v0[3]); w.z = cvt_pk_bf16(v1[0], v1[1]); w.w = cvt_pk_bf16(v1[2], v1[3]);
                        *(u32x4*)(P + (size_t)row * PROJ_LD + col) = w;
                    } else if (colt < 64) {
                        float* d = BA + (size_t)row * 64 + colt; *(f32x4*)d = v0; *(f32x4*)(d + 4) = v1;
                    }
                    if (u.pn < 40) {
                        float* dst = nullptr;
                        if (!sample) {
                            if (tailp) { const int b = row >> 11, t = row & 2047;
                                if (u.pn < 4) { if (t >= SEQ - 15) dst = out + OUT_NPP + ((size_t)(b * 15 + t - (SEQ - 15))) * PW + col; }
                                else          { if (t >= SEQ - 3)  dst = out + OUT_NCP + ((size_t)(b * 3 + t - (SEQ - 3))) * CCH + (col - O1); } }
                        } else { const int s = row - MP, b = s >> 3, t = s & 7;
                            if (u.pn < 4) dst = out + OUT_NPS + ((size_t)(b * 15 + 7 + t)) * PW + col;
                            else if (t >= 5) dst = out + OUT_NCS + ((size_t)(b * 3 + t - 5)) * CCH + (col - O1); }
                        if (dst) { *(f32x4*)dst = v0; *(f32x4*)(dst + 4) = v1; }
                    }
                }
            }
    }
};
struct EpiBf16S {
    static constexpr bool PERM = true;
    bf16_t* O; int ldc; const float* scale;
    __device__ __forceinline__ void operator()(AccRef acc, const Unit& u, int wr, int wc, int fr, int fq) const {
        const int row0 = u.pm * BM + wr * 64 + fr, col0 = u.pn * BM + wc * 32 + 8 * fq;
#pragma unroll
        for (int bj = 0; bj < 2; ++bj) {
            f32x4 s0 = (f32x4){1.f, 1.f, 1.f, 1.f}, s1 = s0;
            if (scale) { s0 = *(const f32x4*)(scale + col0 + bj * HALF); s1 = *(const f32x4*)(scale + col0 + bj * HALF + 4); }
#pragma unroll
            for (int ai = 0; ai < 2; ++ai)
#pragma unroll
                for (int m = 0; m < 4; ++m) {
                    const f32x4 v0 = acc[ai][bj][m][0] * s0, v1 = acc[ai][bj][m][1] * s1;
                    u32x4 w; w.x = cvt_pk_bf16(v0[0], v0[1]); w.y = cvt_pk_bf16(v0[2], v0[3]); w.z = cvt_pk_bf16(v1[0], v1[1]); w.w = cvt_pk_bf16(v1[2], v1[3]);
                    *(u32x4*)(O + (size_t)(row0 + ai * HALF + m * 16) * ldc + col0 + bj * HALF) = w;
                }
        }
    }
};
__device__ __forceinline__ void store_partial(AccRef acc, const Unit& u, float* slab, int wr, int wc, int fr, int fq) {
    const int row0 = (u.pm - 32) * BM + wr * 64 + fr, col0 = u.pn * BM + wc * 32 + 4 * fq; float* S = slab + (size_t)u.split * MS * DM;
#pragma unroll
    for (int ai = 0; ai < 2; ++ai)
#pragma unroll
        for (int m = 0; m < 4; ++m) { const size_t off = (size_t)(row0 + ai * HALF + m * 16) * DM + col0;
#pragma unroll
            for (int bj = 0; bj < 2; ++bj)
#pragma unroll
                for (int n = 0; n < 2; ++n) *(f32x4*)(S + off + bj * HALF + n * 16) = acc[ai][bj][m][n]; }
}
struct EpiResid {
    static constexpr bool PERM = false;
    const float* R0; const float* R1; int split; float* O; float* slab;
    __device__ __forceinline__ void operator()(AccRef acc, const Unit& u, int wr, int wc, int fr, int fq) const {
        if (u.split >= 0) { store_partial(acc, u, slab, wr, wc, fr, fq); return; }
        const int row0 = u.pm * BM + wr * 64 + fr, col0 = u.pn * BM + wc * 32 + 4 * fq;
        const float* R = (u.pm * BM < split) ? R0 : R1 - (size_t)split * DM;
#pragma unroll
        for (int ai = 0; ai < 2; ++ai)
#pragma unroll
            for (int m = 0; m < 4; ++m) { const size_t off = (size_t)(row0 + ai * HALF + m * 16) * DM + col0;
#pragma unroll
                for (int bj = 0; bj < 2; ++bj)
#pragma unroll
                    for (int n = 0; n < 2; ++n) { const f32x4 r = *(const f32x4*)(R + off + bj * HALF + n * 16); *(f32x4*)(O + off + bj * HALF + n * 16) = r * DN_ALPHA + acc[ai][bj][m][n]; } }
    }
};
struct EpiSwiGLU {
    static constexpr bool PERM = true;
    bf16_t* O;
    __device__ __forceinline__ void operator()(AccRef acc, const Unit& u, int wr, int wc, int fr, int fq) const {
        const int row0 = u.pm * BM + wr * 64 + fr, col0 = u.pn * HALF + wc * 32 + 8 * fq;
#pragma unroll
        for (int ai = 0; ai < 2; ++ai)
#pragma unroll
            for (int m = 0; m < 4; ++m) {
                f32x4 a0 = acc[ai][0][m][0], a1 = acc[ai][0][m][1]; const f32x4 b0 = acc[ai][1][m][0], b1 = acc[ai][1][m][1];
#pragma unroll
                for (int j = 0; j < 4; ++j) { a0[j] = a0[j] * fast_sigmoid(a0[j]) * b0[j]; a1[j] = a1[j] * fast_sigmoid(a1[j]) * b1[j]; }
                u32x4 w; w.x = cvt_pk_bf16(a0[0], a0[1]); w.y = cvt_pk_bf16(a0[2], a0[3]); w.z = cvt_pk_bf16(a1[0], a1[1]); w.w = cvt_pk_bf16(a1[2], a1[3]);
                *(u32x4*)(O + (size_t)(row0 + ai * HALF + m * 16) * DFF + col0) = w;
            }
    }
};
struct EpiFinal {
    static constexpr bool PERM = false;
    float* Y; const bf16_t* E; float* slab;
    __device__ __forceinline__ void operator()(AccRef acc, const Unit& u, int wr, int wc, int fr, int fq) const {
        if (u.split >= 0) { store_partial(acc, u, slab, wr, wc, fr, fq); return; }
        const int row0 = u.pm * BM + wr * 64 + fr, col0 = u.pn * BM + wc * 32 + 4 * fq;
#pragma unroll
        for (int ai = 0; ai < 2; ++ai)
#pragma unroll
            for (int m = 0; m < 4; ++m) { const size_t off = (size_t)(row0 + ai * HALF + m * 16) * DM + col0;
#pragma unroll
                for (int bj = 0; bj < 2; ++bj)
#pragma unroll
                    for (int n = 0; n < 2; ++n) { const size_t o = off + bj * HALF + n * 16; const f32x4 h = *(const f32x4*)(Y + o); const u32x2 ew = *(const u32x2*)(E + o);
                        const f32x4 a = acc[ai][bj][m][n]; f32x4 y;
                        y[0] = h[0] + fast_sigmoid(a[0]) * bf_lo(ew.x); y[1] = h[1] + fast_sigmoid(a[1]) * bf_hi(ew.x);
                        y[2] = h[2] + fast_sigmoid(a[2]) * bf_lo(ew.y); y[3] = h[3] + fast_sigmoid(a[3]) * bf_hi(ew.y);
                        *(f32x4*)(Y + o) = y; } }
    }
};

__device__ __forceinline__ void row_mu_rstd(const float* ST, int row, float& mu, float& rstd) { const f32x2 v = *(const f32x2*)(ST + 2 * (size_t)row); mu = v.x; rstd = v.y; }
__device__ __forceinline__ f32x2 stats_finalize(float sm, float sq) { const float mu = sm * (1.0f / DM); return (f32x2){mu, 1.0f / sqrtf(fmaxf(sq * (1.0f / DM) - mu * mu, 0.f) + LN_EPS)}; }
template <int MODE> struct EpiLNRes {
    static constexpr bool PERM = false;
    const float* R0; const bf16_t* RB; bf16_t* TB; float* ST; float* slab; const float* STin; const float* gin; const float* bin; unsigned char* T8 = nullptr; float asc = 1.f;
    __device__ __forceinline__ void operator()(AccRef acc, const Unit& u, int wr, int wc, int fr, int fq) const {
        if (u.split >= 0) { store_partial(acc, u, slab, wr, wc, fr, fq); return; }
        const int row0 = u.pm * BM + wr * 64 + fr, col0 = u.pn * BM + wc * 32 + 4 * fq, lane = fr + 16 * fq;
        f32x4 gg[2][2], bb[2][2];
        if (MODE == 1) {
#pragma unroll
            for (int bj = 0; bj < 2; ++bj)
#pragma unroll
                for (int n = 0; n < 2; ++n) { gg[bj][n] = *(const f32x4*)(gin + col0 + bj * HALF + n * 16); bb[bj][n] = *(const f32x4*)(bin + col0 + bj * HALF + n * 16); }
        }
#pragma unroll
        for (int ai = 0; ai < 2; ++ai)
#pragma unroll
            for (int m = 0; m < 4; ++m) { const int row = row0 + ai * HALF + m * 16; const size_t off = (size_t)row * DM + col0;
                float mu = 0.f, rs = 1.f; if (MODE == 1) row_mu_rstd(STin, row, mu, rs);
                float sm = 0.f, sq = 0.f;
#pragma unroll
                for (int bj = 0; bj < 2; ++bj)
#pragma unroll
                    for (int n = 0; n < 2; ++n) { f32x4 r;
                        { const u32x2 rw = *(const u32x2*)(RB + off + bj * HALF + n * 16); r = (f32x4){bf_lo(rw.x), bf_hi(rw.x), bf_lo(rw.y), bf_hi(rw.y)}; }
                        if (MODE == 1) r = (r - mu) * rs * gg[bj][n] + bb[bj][n];
                        const f32x4 t = r * DN_ALPHA + acc[ai][bj][m][n] * asc;
                        u32x2 w; w.x = cvt_pk_bf16(t[0], t[1]); w.y = cvt_pk_bf16(t[2], t[3]); *(u32x2*)(TB + off + bj * HALF + n * 16) = w;
                        if (MODE == 1) *(unsigned*)(T8 + off + bj * HALF + n * 16) = pk4_fp8(t[0], t[1], t[2], t[3]);
                        else if (T8) *(unsigned*)(T8 + off + bj * HALF + n * 16) = pk4_i8(t[0] * A8I_INV, t[1] * A8I_INV, t[2] * A8I_INV, t[3] * A8I_INV);
                        sm += (t[0] + t[1]) + (t[2] + t[3]); sq += (t[0] * t[0] + t[1] * t[1]) + (t[2] * t[2] + t[3] * t[3]); }
                sm += swz_xor<16>(sm); sq += swz_xor<16>(sq);
                sm += bperm_f(lane ^ 32, sm); sq += bperm_f(lane ^ 32, sq);
                if (fq == 0) *(f32x2*)(ST + ((size_t)row * 64 + u.pn * 4 + wc) * 2) = (f32x2){sm, sq}; }
    }
};
struct EpiSwiGLULN {
    static constexpr bool PERM = true;
    bf16_t* O; const float* ST; const float* C1; const float* C2; float* slab2; float asc = 0.f; int only = -1; bool wt = false;
    __device__ __forceinline__ f32x4 accf(const f32x4& a) const { return asc != 0.f ? __builtin_convertvector(__builtin_bit_cast(i32x4_t, a), f32x4) * asc : a; }
    __device__ __forceinline__ void operator()(AccRef acc, const Unit& u, int wr, int wc, int fr, int fq) const {
        if (u.split >= 0) { f32x4* d = (f32x4*)slab2 + ((size_t)((u.aux * 8 + u.split) * 8 + wr * 4 + wc) * 32) * 64 + fr + 16 * fq;
#pragma unroll
            for (int ai = 0; ai < 2; ++ai)
#pragma unroll
                for (int bj = 0; bj < 2; ++bj)
#pragma unroll
                    for (int m = 0; m < 4; ++m)
#pragma unroll
                        for (int n = 0; n < 2; ++n) d[(((ai * 2 + bj) * 4 + m) * 2 + n) * 64] = accf(acc[ai][bj][m][n]);
            return; }
        const int row0 = u.pm * BM + wr * 64 + fr, col0 = u.pn * HALF + wc * 32 + 8 * fq, cw = u.pn * BM + wc * 32 + 8 * fq;
        f32x4 c1[2][2], c2[2][2];
#pragma unroll
        for (int bj = 0; bj < 2; ++bj)
#pragma unroll
            for (int n = 0; n < 2; ++n) { c1[bj][n] = *(const f32x4*)(C1 + cw + bj * HALF + 4 * n); c2[bj][n] = *(const f32x4*)(C2 + cw + bj * HALF + 4 * n); }
#pragma unroll
        for (int ai = 0; ai < 2; ++ai)
#pragma unroll
            for (int m = 0; m < 4; ++m) { if (only >= 0 && only != ai * 4 + m) continue;
                const int row = row0 + ai * HALF + m * 16; float mu, rs; row_mu_rstd(ST, row, mu, rs);
                f32x4 a0 = (accf(acc[ai][0][m][0]) - c1[0][0] * mu) * rs + c2[0][0], a1 = (accf(acc[ai][0][m][1]) - c1[0][1] * mu) * rs + c2[0][1];
                const f32x4 b0 = (accf(acc[ai][1][m][0]) - c1[1][0] * mu) * rs + c2[1][0], b1 = (accf(acc[ai][1][m][1]) - c1[1][1] * mu) * rs + c2[1][1];
#pragma unroll
                for (int j = 0; j < 4; ++j) { a0[j] = a0[j] * fast_sigmoid(a0[j]) * b0[j]; a1[j] = a1[j] * fast_sigmoid(a1[j]) * b1[j]; }
                u32x2 w; w.x = pk4_fp8(a0[0] * ACT8_SCALE, a0[1] * ACT8_SCALE, a0[2] * ACT8_SCALE, a0[3] * ACT8_SCALE); w.y = pk4_fp8(a1[0] * ACT8_SCALE, a1[1] * ACT8_SCALE, a1[2] * ACT8_SCALE, a1[3] * ACT8_SCALE);
                if (wt) st_wt8x((unsigned char*)O + (size_t)row * DFF + col0, w); else *(u32x2*)((unsigned char*)O + (size_t)row * DFF + col0) = w; }
    }
};
struct EpiFinalLN {
    static constexpr bool PERM = false;
    float* Y; const bf16_t* TB; const bf16_t* E; float* slab; const float* ST; const float* C1; const float* C2; const float* gin; const float* bin;
    __device__ __forceinline__ void operator()(AccRef acc, const Unit& u, int wr, int wc, int fr, int fq) const {
        if (u.split >= 0) { store_partial(acc, u, slab, wr, wc, fr, fq); return; }
        const int row0 = u.pm * BM + wr * 64 + fr, col0 = u.pn * BM + wc * 32 + 4 * fq;
        f32x4 gg[2][2], bb[2][2], c1[2][2], c2[2][2];
#pragma unroll
        for (int bj = 0; bj < 2; ++bj)
#pragma unroll
            for (int n = 0; n < 2; ++n) { const int c = col0 + bj * HALF + n * 16; gg[bj][n] = *(const f32x4*)(gin + c); bb[bj][n] = *(const f32x4*)(bin + c); c1[bj][n] = *(const f32x4*)(C1 + c); c2[bj][n] = *(const f32x4*)(C2 + c); }
#pragma unroll
        for (int ai = 0; ai < 2; ++ai)
#pragma unroll
            for (int m = 0; m < 4; ++m) { const int row = row0 + ai * HALF + m * 16; const size_t off = (size_t)row * DM + col0; float mu, rs; row_mu_rstd(ST, row, mu, rs);
#pragma unroll
                for (int bj = 0; bj < 2; ++bj)
#pragma unroll
                    for (int n = 0; n < 2; ++n) { const size_t o = off + bj * HALF + n * 16; const u32x2 tw = *(const u32x2*)(TB + o); const f32x4 t = (f32x4){bf_lo(tw.x), bf_hi(tw.x), bf_lo(tw.y), bf_hi(tw.y)}; const u32x2 ew = *(const u32x2*)(E + o);
                        const f32x4 h = (t - mu) * rs * gg[bj][n] + bb[bj][n]; const f32x4 a = (acc[ai][bj][m][n] * W8_INV - c1[bj][n] * mu) * rs + c2[bj][n]; f32x4 y;
                        y[0] = h[0] + fast_sigmoid(a[0]) * bf_lo(ew.x); y[1] = h[1] + fast_sigmoid(a[1]) * bf_hi(ew.x);
                        y[2] = h[2] + fast_sigmoid(a[2]) * bf_lo(ew.y); y[3] = h[3] + fast_sigmoid(a[3]) * bf_hi(ew.y);
                        *(f32x4*)(Y + o) = y; } }
    }
};
}

#define XB_TMO      128
#define XB_XCNT(j)  (256  + 64 * (j))
#define XB_XSUB(j)  (1280 + 64 * (j))
#define XB_XGEN(j)  (2304 + 64 * (j))
#define XB_TOP      3328
#define XB_TOPGEN   3392
#define XCD_BAR_WORDS 3456
#define XB_SPIN_CAP (1u << 18)
__device__ __forceinline__ unsigned xb_ld(unsigned* p)              { return __hip_atomic_load(p, __ATOMIC_RELAXED, __HIP_MEMORY_SCOPE_AGENT); }
__device__ __forceinline__ unsigned xb_add(unsigned* p, unsigned v) { return __hip_atomic_fetch_add(p, v, __ATOMIC_RELAXED, __HIP_MEMORY_SCOPE_AGENT); }
__device__ __forceinline__ unsigned xb_xcc_id() { return (unsigned)__builtin_amdgcn_s_getreg((3 << 11) | 20) & 0xFu; }
#define XB_SPIN(cond, bar) do { unsigned _sp = 0; while (cond) { __builtin_amdgcn_s_sleep(1); \
    if ((++_sp & 255u) == 0u) { if (xb_ld(&(bar)[XB_TMO])) break; if (_sp > XB_SPIN_CAP) { atomicAdd(&(bar)[XB_TMO], 1u); break; } } } } while (0)
struct XcdBarrier { unsigned* bar; unsigned x; volatile LAS unsigned* st; };
__device__ __forceinline__ XcdBarrier xcd_barrier_post(unsigned* bar, volatile LAS unsigned* st) {
    XcdBarrier b; b.bar = bar; b.x = xb_xcc_id(); b.st = st;
    if (threadIdx.x == 0) (void)xb_add(&bar[XB_XCNT(b.x)], 1u);
    return b;
}
__device__ __forceinline__ void xcd_barrier_complete(unsigned* bar, unsigned x, unsigned& nloc, unsigned& nx) {
    const unsigned G = gridDim.x * gridDim.y * gridDim.z;
    unsigned sum, cnt, mine, sp = 0u;
    for (;;) {
        sum = 0u; cnt = 0u; mine = 0u;
#pragma unroll
        for (unsigned j = 0; j < 16; ++j) { const unsigned c = xb_ld(&bar[XB_XCNT(j)]); sum += c; cnt += (c > 0u) ? 1u : 0u; mine = (j == x) ? c : mine; }
        if (sum == G) break;
        __builtin_amdgcn_s_sleep(1);
        if ((++sp & 255u) == 0u) { if (xb_ld(&bar[XB_TMO])) break; if (sp > XB_SPIN_CAP) { atomicAdd(&bar[XB_TMO], 1u); break; } }
    }
    nloc = mine > 0u ? mine : 1u; nx = cnt > 0u ? cnt : 1u;
}
__device__ __forceinline__ void xcd_barrier(const XcdBarrier& b) {
    asm volatile("s_waitcnt vmcnt(0)" ::: "memory");
    __syncthreads();
    if (threadIdx.x == 0) {
        unsigned* bar = b.bar;
        __builtin_amdgcn_s_waitcnt(0);
        unsigned nloc = b.st[0], nx = b.st[1];
        if (nloc == 0u) { xcd_barrier_complete(bar, b.x, nloc, nx); b.st[0] = nloc; b.st[1] = nx; }
        const unsigned old = xb_add(&bar[XB_XSUB(b.x)], 1u);
        const unsigned gen = old / nloc;
        if (old + 1u == (gen + 1u) * nloc) {
            __builtin_amdgcn_fence(__ATOMIC_RELEASE, "agent");
            asm volatile("s_waitcnt vmcnt(0)" ::: "memory");
            const unsigned og = xb_add(&bar[XB_TOP], 1u);
            const unsigned tg = og / nx;
            if (og + 1u == (tg + 1u) * nx) xb_add(&bar[XB_TOPGEN], 1u);
            else XB_SPIN(xb_ld(&bar[XB_TOPGEN]) == tg, bar);
            __builtin_amdgcn_fence(__ATOMIC_ACQUIRE, "agent");
            xb_add(&bar[XB_XGEN(b.x)], 1u);
            asm volatile("s_waitcnt vmcnt(0)" ::: "memory");
        } else {
            XB_SPIN(xb_ld(&bar[XB_XGEN(b.x)]) == gen, bar);
            __builtin_amdgcn_fence(__ATOMIC_ACQUIRE, "agent");
            asm volatile("s_waitcnt vmcnt(0)" ::: "memory");
        }
    }
    __syncthreads();
}

struct Args { const float* in[23]; float* out; unsigned char* ws; int pad0, pad1; };

template <int MODE, int LNF = 0, int F8 = 0, int I8 = 0>
__device__ __forceinline__ void transpose_item(const float* __restrict__ W, int K, int N, bf16_t* WT, LAS float* scr, int item, int lane,
                                               const float* __restrict__ lng = nullptr, const float* __restrict__ lnb = nullptr, float* c1 = nullptr, float* c2 = nullptr) {
    const int nblk = (N + 31) / 32, kb = item / nblk, nb = item % nblk, k0 = 64 * kb, n0 = 32 * nb;
    const int nn = n0 + (lane & 31); const bool ok = nn < N; const int hi = lane >> 5;
    float wv[32];
    const float* wp = W + (size_t)(k0 + hi) * N + (ok ? nn : 0);
#pragma unroll
    for (int i = 0; i < 32; ++i) wv[i] = wp[(size_t)(2 * i) * N];
    if (LNF) {
        float s1 = 0.f, s2 = 0.f;
#pragma unroll
        for (int i = 0; i < 32; ++i) { const float g0 = lng[k0 + 2 * i], g1 = lng[k0 + 2 * i + 1], b0 = lnb[k0 + 2 * i], b1 = lnb[k0 + 2 * i + 1];
            const float gk = hi ? g1 : g0, bk = hi ? b1 : b0; s2 += wv[i] * bk; wv[i] *= gk; s1 += wv[i]; }
        s1 += bperm_f(lane ^ 32, s1); s2 += bperm_f(lane ^ 32, s2);
        if (hi == 0 && ok) { int drow = nn;
            if (MODE == 1) { const bool up = drow >= DFF; const int f = up ? drow - DFF : drow; drow = 256 * (f >> 7) + (f & 127) + (up ? 128 : 0); }
            c1[(size_t)kb * CP_N + drow] = s1; c2[(size_t)kb * CP_N + drow] = s2; }
    }
#pragma unroll
    for (int i = 0; i < 32; ++i) scr[(2 * i + hi) * 33 + (lane & 31)] = ok ? wv[i] : 0.f;
    LDS_WAIT(); asm volatile("" ::: "memory");
    const int c = lane & 7;
#pragma unroll
    for (int j = 0; j < 4; ++j) { const int n = (lane >> 3) + 8 * j; const LAS float* sp = scr + (8 * c) * 33 + n;
        u32x4 o; o.x = pk2(sp[0 * 33], sp[1 * 33]); o.y = pk2(sp[2 * 33], sp[3 * 33]); o.z = pk2(sp[4 * 33], sp[5 * 33]); o.w = pk2(sp[6 * 33], sp[7 * 33]);
        int drow = n0 + n;
        if (MODE == 1) { const bool up = drow >= DFF; const int f = up ? drow - DFF : drow; drow = 256 * (f >> 7) + (f & 127) + (up ? 128 : 0); }
        if (I8) { u32x2 o8; o8.x = pg8::pk4_i8(sp[0 * 33] * W8I_INV, sp[1 * 33] * W8I_INV, sp[2 * 33] * W8I_INV, sp[3 * 33] * W8I_INV); o8.y = pg8::pk4_i8(sp[4 * 33] * W8I_INV, sp[5 * 33] * W8I_INV, sp[6 * 33] * W8I_INV, sp[7 * 33] * W8I_INV);
            *(GAS u32x2*)((unsigned char*)WT + (size_t)drow * K + k0 + 8 * c) = o8; }
        else if (F8) { u32x2 o8; o8.x = pg8::pk4_fp8(sp[0 * 33] * (float)F8, sp[1 * 33] * (float)F8, sp[2 * 33] * (float)F8, sp[3 * 33] * (float)F8); o8.y = pg8::pk4_fp8(sp[4 * 33] * (float)F8, sp[5 * 33] * (float)F8, sp[6 * 33] * (float)F8, sp[7 * 33] * (float)F8);
            *(GAS u32x2*)((unsigned char*)WT + (size_t)drow * K + k0 + 8 * c) = o8; }
        else *(GAS u32x4*)(WT + (size_t)drow * K + k0 + 8 * c) = o; }
    LDS_WAIT(); asm volatile("" ::: "memory");
}

__device__ __forceinline__ void st_wt16(void* p, f32x4 v) { asm volatile("global_store_dwordx4 %0, %1, off sc1\n\ts_nop 1" :: "v"(p), "v"(v) : "memory"); }
__device__ __forceinline__ void st_wt8(void* p, u32x2 v) { asm volatile("global_store_dwordx2 %0, %1, off sc1\n\ts_nop 1" :: "v"(p), "v"(v) : "memory"); }
__device__ __forceinline__ void st_wt8f(void* p, f32x2 v) { asm volatile("global_store_dwordx2 %0, %1, off sc1\n\ts_nop 1" :: "v"(p), "v"(v) : "memory"); }
__device__ __forceinline__ void st_wt4(void* p, unsigned v) { asm volatile("global_store_dword %0, %1, off sc1\n\ts_nop 1" :: "v"(p), "v"(v) : "memory"); }
template <int MODE>
__device__ __forceinline__ void sample_rows_t(const float* xs, const float* slab, float* Y, bf16_t* TB, float* ST, const float* STin, const float* __restrict__ gin, const float* __restrict__ bin, int gw, int NGW, int lane, unsigned char* T8 = nullptr, float pscale = 1.f) {
#pragma unroll 1
    for (int m = MP + gw; m < M; m += NGW) {
        const size_t ro = (size_t)(m - MP) * DM; const f32x4* rr = (const f32x4*)((MODE == 0 ? xs + ro : Y + (size_t)m * DM)) + lane;
        const f32x4* p0 = (const f32x4*)(slab + ro) + lane; const f32x4* p1 = p0 + (size_t)MS * DM / 4; const f32x4* p2 = p1 + (size_t)MS * DM / 4; const f32x4* p3 = p2 + (size_t)MS * DM / 4;
        float mu = 0.f, rs = 1.f; if (MODE == 1) pg8::row_mu_rstd(STin, m, mu, rs);
        f32x4 v[16]; float sm = 0.f, sq = 0.f;
#pragma unroll
        for (int j = 0; j < 16; ++j) { f32x4 r = rr[64 * j];
            if (MODE == 1) r = (r - mu) * rs * ((const f32x4*)gin)[lane + 64 * j] + ((const f32x4*)bin)[lane + 64 * j];
            v[j] = r * DN_ALPHA + ((p0[64 * j] + p1[64 * j]) + (p2[64 * j] + p3[64 * j])) * pscale;
            sm += (v[j].x + v[j].y) + (v[j].z + v[j].w); sq += (v[j].x * v[j].x + v[j].y * v[j].y) + (v[j].z * v[j].z + v[j].w * v[j].w);
            if ((j & 3) == 3) asm volatile("" ::: "memory"); }
        sm = wave_sum(sm); sq = wave_sum(sq);
        f32x4* of = (f32x4*)(Y + (size_t)m * DM) + lane; u32x2* ob = (u32x2*)(TB + (size_t)m * DM) + lane;
#pragma unroll
        for (int j = 0; j < 16; ++j) { st_wt16(of + 64 * j, v[j]); u32x2 w; w.x = pk2(v[j].x, v[j].y); w.y = pk2(v[j].z, v[j].w); st_wt8(ob + 64 * j, w);
            if (MODE == 1) st_wt4((unsigned*)(T8 + (size_t)m * DM) + lane + 64 * j, pg8::pk4_fp8(v[j].x, v[j].y, v[j].z, v[j].w));
            else if (T8) st_wt4((unsigned*)(T8 + (size_t)m * DM) + lane + 64 * j, pg8::pk4_i8(v[j].x * A8I_INV, v[j].y * A8I_INV, v[j].z * A8I_INV, v[j].w * A8I_INV)); }
        if (lane == 0) st_wt8f(ST + 2 * (size_t)m, pg8::stats_finalize(sm, sq));
    }
}

__device__ __forceinline__ void prompt_rows_stats(const float* PST, float* ST, int gtid, int gthreads) {
    for (int m = gtid; m < MP; m += gthreads) { const f32x4* p = (const f32x4*)(PST + (size_t)m * 128); float sm = 0.f, sq = 0.f;
#pragma unroll
        for (int j = 0; j < 32; ++j) { const f32x4 v = p[j]; sm += v.x + v.z; sq += v.y + v.w; }
        *(f32x2*)(ST + 2 * (size_t)m) = pg8::stats_finalize(sm, sq); }
}
__device__ __forceinline__ void prompt_rows_stats_w(const float* PST, float* ST, int row0, int lane) {
    f32x2 v[8];
#pragma unroll
    for (int r = 0; r < 8; ++r) v[r] = *(const f32x2*)(PST + (size_t)(row0 + r) * 128 + 2 * lane);
#pragma unroll
    for (int r = 0; r < 8; ++r) { const float sm = wave_sum(v[r].x), sq = wave_sum(v[r].y); if (lane == 0) st_wt8f(ST + 2 * (size_t)(row0 + r), pg8::stats_finalize(sm, sq)); }
}
template <int MODE>
__device__ __forceinline__ void rows_pass(const float* xs, const float* slab, float* Y, bf16_t* TB, const float* PST, float* ST, const float* STin, const float* gin, const float* bin, unsigned* cnt, int vcu, int G, int wave, int lane, unsigned char* T8 = nullptr, float pscale = 1.f) {
    if (wave < 4) sample_rows_t<MODE>(xs, slab, Y, TB, ST, STin, gin, bin, vcu * 4 + wave, G * 4, lane, T8, pscale);
    else { for (int rb = (vcu * 4 + wave - 4) * 8; rb < MP; rb += G * 32) prompt_rows_stats_w(PST, ST, rb, lane); }
    asm volatile("s_waitcnt vmcnt(0)" ::: "memory"); __syncthreads();
    if (wave == 0 && lane == 0) __hip_atomic_fetch_add(cnt, 1u, __ATOMIC_RELAXED, __HIP_MEMORY_SCOPE_AGENT);
}
__device__ __forceinline__ void ln_rows(const float* in, const float* res, const float* slab, float* outf, bf16_t* outb, const float* __restrict__ g, const float* __restrict__ b, int gw, int NGW, int lane) {
#pragma unroll 1
    for (int m = gw; m < M; m += NGW) {
        f32x4 v[16]; float s = 0.f;
        if (m < MP) {
            const f32x4* xr = (const f32x4*)(in + (size_t)m * DM) + lane;
#pragma unroll
            for (int j = 0; j < 16; ++j) v[j] = xr[64 * j];
        } else {
            const size_t ro = (size_t)(m - MP) * DM; const f32x4* rr = (const f32x4*)(res + ro) + lane;
            const f32x4* p0 = (const f32x4*)(slab + ro) + lane; const f32x4* p1 = p0 + (size_t)MS * DM / 4; const f32x4* p2 = p1 + (size_t)MS * DM / 4; const f32x4* p3 = p2 + (size_t)MS * DM / 4;
#pragma unroll
            for (int j = 0; j < 16; ++j) { v[j] = rr[64 * j] * DN_ALPHA + ((p0[64 * j] + p1[64 * j]) + (p2[64 * j] + p3[64 * j])); if ((j & 3) == 3) asm volatile("" ::: "memory"); }
        }
#pragma unroll
        for (int j = 0; j < 16; ++j) { s += (v[j].x + v[j].y) + (v[j].z + v[j].w); }
        const float mean = wave_sum(s) * (1.f / DM); float s2 = 0.f;
#pragma unroll
        for (int j = 0; j < 16; ++j) { v[j] = v[j] - mean; s2 += (v[j].x * v[j].x + v[j].y * v[j].y) + (v[j].z * v[j].z + v[j].w * v[j].w); }
        const float rstd = 1.0f / sqrtf(wave_sum(s2) * (1.f / DM) + LN_EPS);
        f32x4* of = (f32x4*)(outf + (size_t)m * DM) + lane; u32x2* ob = (u32x2*)(outb + (size_t)m * DM) + lane;
#pragma unroll
        for (int j = 0; j < 16; ++j) { const f32x4 gg = ((const f32x4*)g)[lane + 64 * j], bb = ((const f32x4*)b)[lane + 64 * j];
            const f32x4 y = v[j] * rstd * gg + bb; of[64 * j] = y; u32x2 w; w.x = pk2(y.x, y.y); w.y = pk2(y.z, y.w); ob[64 * j] = w;
            if ((j & 3) == 3) asm volatile("" ::: "memory"); }
    }
}

__device__ __forceinline__ void bf8_to_f32(const u32x4 w, float (&f)[8]) {
    f[0] = bf_lo(w.x); f[1] = bf_hi(w.x); f[2] = bf_lo(w.y); f[3] = bf_hi(w.y); f[4] = bf_lo(w.z); f[5] = bf_hi(w.z); f[6] = bf_lo(w.w); f[7] = bf_hi(w.w);
}

typedef float f32x16 __attribute__((ext_vector_type(16)));
typedef __bf16 bf16x2_t __attribute__((ext_vector_type(2)));
#define MFMA32(a, b, c) __builtin_amdgcn_mfma_f32_32x32x16_bf16((a), (b), (c), 0, 0, 0)
__device__ __forceinline__ unsigned cvtpk(float lo, float hi) { f32x2 v = {lo, hi}; bf16x2_t b = __builtin_convertvector(v, bf16x2_t); return __builtin_bit_cast(unsigned, b); }
template <int S> __device__ __forceinline__ bf16x8 pack8(const f32x16& x) {
    u32x4 p; p.x = cvtpk(x[8 * S], x[8 * S + 1]); p.y = cvtpk(x[8 * S + 2], x[8 * S + 3]); p.z = cvtpk(x[8 * S + 4], x[8 * S + 5]); p.w = cvtpk(x[8 * S + 6], x[8 * S + 7]);
    return __builtin_bit_cast(bf16x8, p);
}
__device__ __forceinline__ int crow(int r, int hi) { return (r & 3) + 8 * (r >> 2) + 4 * hi; }

constexpr int SL_KQ = 0, SL_X = 4352, SL_KDT = 8704, SL_U = 10752, SL_AT = 14848, SL_QK = 15104, SL_TT = 15360, SL_TAB = 15616, SL_BYTES = 16384;
__device__ __forceinline__ void sample_task(const float* __restrict__ wconv, const float* __restrict__ sconv, int bidx, const float* __restrict__ BAq, const float* __restrict__ alog, const float* __restrict__ dtb,
                                            const float* __restrict__ S0, float* Sout, const bf16_t* __restrict__ proj, const float* __restrict__ ong, bf16_t* mixed, int row0, int h, LAS unsigned char* wl, int lane) {
    asm volatile("" : "+v"(wl));
    LAS bf16_t* KQ = (LAS bf16_t*)(wl + SL_KQ); LAS bf16_t* X = (LAS bf16_t*)(wl + SL_X); LAS bf16_t* KDT = (LAS bf16_t*)(wl + SL_KDT); LAS float* U = (LAS float*)(wl + SL_U);
    LAS float* AT = (LAS float*)(wl + SL_AT); LAS float* QKm = (LAS float*)(wl + SL_QK); LAS float* TT = (LAS float*)(wl + SL_TT); LAS float* tab = (LAS float*)(wl + SL_TAB);
    LAS float* OS = (LAS float*)(wl + SL_KQ);
    const int l31 = lane & 31, hi = lane >> 5;
    { const int row = lane >> 3, seg = lane & 7;
#pragma unroll
      for (int tn = 0; tn < 3; ++tn) {
          float acc[16];
#pragma unroll
          for (int e = 0; e < 16; ++e) acc[e] = 0.f;
          const int chb = tn * DNW + h * HD + seg * 16;
#pragma unroll
          for (int j = 0; j < 4; ++j) { const int tt = row - 3 + j; float x[16];
              if (tt >= 0) { const bf16_t* p = proj + (size_t)(row0 + tt) * PROJ_LD + O1 + chb; float a8[8], b8[8]; bf8_to_f32(*(const u32x4*)p, a8); bf8_to_f32(*(const u32x4*)(p + 8), b8);
#pragma unroll
                  for (int e = 0; e < 8; ++e) { x[e] = a8[e]; x[8 + e] = b8[e]; } }
              else { const float* sp = sconv + ((size_t)(bidx * 3 + 3 + tt)) * CCH + chb;
#pragma unroll
                  for (int q4 = 0; q4 < 4; ++q4) { const f32x4 t = *(const f32x4*)(sp + 4 * q4); x[4 * q4] = t[0]; x[4 * q4 + 1] = t[1]; x[4 * q4 + 2] = t[2]; x[4 * q4 + 3] = t[3]; } }
              const float* wp = wconv + (size_t)j * CCH + chb;
#pragma unroll
              for (int q4 = 0; q4 < 4; ++q4) { const f32x4 w = *(const f32x4*)(wp + 4 * q4);
#pragma unroll
                  for (int e = 0; e < 4; ++e) acc[4 * q4 + e] += x[4 * q4 + e] * w[e]; } }
          float ss = 0.f;
#pragma unroll
          for (int e = 0; e < 16; ++e) { acc[e] = acc[e] * fast_sigmoid(acc[e]); ss += acc[e] * acc[e]; }
          if (tn < 2) { ss += swz_xor<1>(ss); ss += swz_xor<2>(ss); ss += swz_xor<4>(ss); float rn = __builtin_amdgcn_rsqf(ss + L2_EPS); if (tn == 0) rn *= 0.08838834764831845f;
#pragma unroll
              for (int e = 0; e < 16; ++e) acc[e] *= rn; }
          u32x4 p0, p1; p0.x = pk2(acc[0], acc[1]); p0.y = pk2(acc[2], acc[3]); p0.z = pk2(acc[4], acc[5]); p0.w = pk2(acc[6], acc[7]);
          p1.x = pk2(acc[8], acc[9]); p1.y = pk2(acc[10], acc[11]); p1.z = pk2(acc[12], acc[13]); p1.w = pk2(acc[14], acc[15]);
          LAS bf16_t* dst = (tn == 0 ? KQ + (8 + row) * 136 : tn == 1 ? KQ + row * 136 : X + row * 136) + seg * 16;
          *(LAS u32x4*)dst = p0; *(LAS u32x4*)(dst + 8) = p1;
      } }
    asm volatile("s_waitcnt lgkmcnt(0)" ::: "memory");
    unsigned kc[8], vc[8], qc[8];
#pragma unroll
    for (int j = 0; j < 8; ++j) { kc[j] = *(const LAS unsigned*)(KQ + j * 136 + 2 * lane); qc[j] = *(const LAS unsigned*)(KQ + (8 + j) * 136 + 2 * lane); vc[j] = *(const LAS unsigned*)(X + j * 136 + 2 * lane); }
    if (lane < 16) { const int tr = lane & 7; const float raw = BAq[(size_t)(row0 + tr) * 64 + (lane < 8 ? NH + h : h)];
        float val; if (lane < 8) { const float xx = raw + dtb[h]; val = -expf(alog[h]) * (fmaxf(xx, 0.f) + log1pf(expf(-fabsf(xx)))); } else val = 1.0f / (1.0f + expf(-raw));
        tab[lane] = val; }
    asm volatile("s_waitcnt lgkmcnt(0)" ::: "memory");
    float gc[8], be[8];
    { const f32x4 g0 = *(const LAS f32x4*)(tab), g1 = *(const LAS f32x4*)(tab + 4), b0 = *(const LAS f32x4*)(tab + 8), b1 = *(const LAS f32x4*)(tab + 12);
      gc[0] = g0[0]; gc[1] = gc[0] + g0[1]; gc[2] = gc[1] + g0[2]; gc[3] = gc[2] + g0[3]; gc[4] = gc[3] + g1[0]; gc[5] = gc[4] + g1[1]; gc[6] = gc[5] + g1[2]; gc[7] = gc[6] + g1[3];
      be[0] = b0[0]; be[1] = b0[1]; be[2] = b0[2]; be[3] = b0[3]; be[4] = b1[0]; be[5] = b1[1]; be[6] = b1[2]; be[7] = b1[3]; }
    { f32x16 Dk, Dq;
#pragma unroll
      for (int r = 0; r < 16; ++r) { Dk[r] = 0.f; Dq[r] = 0.f; }
      const int rr = l31 & 7;
#pragma unroll
      for (int s2 = 0; s2 < 8; ++s2) { const bf16x8 kf = *(const LAS bf16x8*)(KQ + rr * 136 + 16 * s2 + 8 * hi), qf = *(const LAS bf16x8*)(KQ + (8 + rr) * 136 + 16 * s2 + 8 * hi);
          Dk = MFMA32(kf, kf, Dk); Dq = MFMA32(qf, kf, Dq); }
      if (l31 < 8) { const int j = l31;
#pragma unroll
          for (int r = 0; r < 4; ++r) { const int i = 4 * hi + r; const float gi = hi ? gc[4 + r] : gc[r], bi = hi ? be[4 + r] : be[r];
              float gj = gc[0];
#pragma unroll
              for (int e = 1; e < 8; ++e) gj = (j == e) ? gc[e] : gj;
              const float dec = __expf(gi - gj);
              AT[j * 8 + i] = (i > j) ? bi * dec * Dk[r] : 0.f; QKm[i * 8 + j] = (i >= j) ? dec * Dq[r] : 0.f; } }
    }
    asm volatile("s_waitcnt lgkmcnt(0)" ::: "memory");
    if (lane < 8) { float T[8];
#pragma unroll
        for (int c = 7; c >= 0; --c) { float a = (lane == c) ? 1.f : 0.f;
#pragma unroll
            for (int j = c + 1; j < 8; ++j) a -= T[j] * AT[c * 8 + j];
            T[c] = a; }
        *(LAS f32x4*)(TT + lane * 8) = (f32x4){T[0], T[1], T[2], T[3]}; *(LAS f32x4*)(TT + lane * 8 + 4) = (f32x4){T[4], T[5], T[6], T[7]}; }
    asm volatile("s_waitcnt lgkmcnt(0)" ::: "memory");
    { float eg[8], ed[8];
#pragma unroll
      for (int i = 0; i < 8; ++i) { eg[i] = __expf(gc[i]); ed[i] = __expf(gc[7] - gc[i]); }
      float vb0[8], vb1[8], kg0[8], kg1[8];
#pragma unroll
      for (int j = 0; j < 8; ++j) { vb0[j] = bf_lo(vc[j]) * be[j]; vb1[j] = bf_hi(vc[j]) * be[j]; const float sc = be[j] * eg[j]; kg0[j] = bf_lo(kc[j]) * sc; kg1[j] = bf_hi(kc[j]) * sc; }
      float kd0[8], kd1[8];
#pragma unroll
      for (int i = 0; i < 8; ++i) {
          const f32x4 t0 = *(const LAS f32x4*)(TT + i * 8), t1 = *(const LAS f32x4*)(TT + i * 8 + 4); const float t[8] = {t0[0], t0[1], t0[2], t0[3], t1[0], t1[1], t1[2], t1[3]};
          float u0 = 0.f, u1 = 0.f, w0 = 0.f, w1 = 0.f;
#pragma unroll
          for (int j = 0; j <= i; ++j) { u0 += t[j] * vb0[j]; u1 += t[j] * vb1[j]; w0 += t[j] * kg0[j]; w1 += t[j] * kg1[j]; }
          *(LAS f32x2*)(U + i * 128 + 2 * lane) = (f32x2){u0, u1};
          *(LAS unsigned*)(X + i * 136 + 2 * lane) = cvtpk(-w0, -w1);
          *(LAS unsigned*)(X + (8 + i) * 136 + 2 * lane) = cvtpk(bf_lo(qc[i]) * eg[i], bf_hi(qc[i]) * eg[i]);
          kd0[i] = bf_lo(kc[i]) * ed[i]; kd1[i] = bf_hi(kc[i]) * ed[i]; }
      u32x4 p0, p1; p0.x = cvtpk(kd0[0], kd0[1]); p0.y = cvtpk(kd0[2], kd0[3]); p0.z = cvtpk(kd0[4], kd0[5]); p0.w = cvtpk(kd0[6], kd0[7]);
      p1.x = cvtpk(kd1[0], kd1[1]); p1.y = cvtpk(kd1[2], kd1[3]); p1.z = cvtpk(kd1[4], kd1[5]); p1.w = cvtpk(kd1[6], kd1[7]);
      *(LAS u32x4*)(KDT + (2 * lane) * 8) = p0; *(LAS u32x4*)(KDT + (2 * lane + 1) * 8) = p1; }
    asm volatile("s_waitcnt lgkmcnt(0)" ::: "memory");
    bf16x8 Xf[8], KDX[4], QKX;
    { const bool act = l31 < 16;
#pragma unroll
      for (int ks = 0; ks < 8; ++ks) { const int k0 = 32 * (ks >> 1) + 16 * (ks & 1) + 4 * hi; u32x4 p = (u32x4){0u, 0u, 0u, 0u};
          if (act) { const u32x2 a = *(const LAS u32x2*)(X + l31 * 136 + k0), b = *(const LAS u32x2*)(X + l31 * 136 + k0 + 8); p.x = a.x; p.y = a.y; p.z = b.x; p.w = b.y; }
          Xf[ks] = __builtin_bit_cast(bf16x8, p); }
#pragma unroll
      for (int kt = 0; kt < 4; ++kt) { const u32x2 a = *(const LAS u32x2*)(KDT + (32 * kt + l31) * 8 + 4 * hi); u32x4 p; p.x = a.x; p.y = a.y; p.z = 0u; p.w = 0u; KDX[kt] = __builtin_bit_cast(bf16x8, p); }
      u32x4 p = (u32x4){0u, 0u, 0u, 0u};
      if (l31 >= 8 && l31 < 16) { const f32x4 qv = *(const LAS f32x4*)(QKm + (l31 - 8) * 8 + 4 * hi); p.x = cvtpk(qv[0], qv[1]); p.y = cvtpk(qv[2], qv[3]); }
      QKX = __builtin_bit_cast(bf16x8, p); }
    const float al = __expf(gc[7]);
#pragma unroll 1
    for (int vt = 0; vt < 4; ++vt) {
        f32x16 S[4];
        const float* sp = S0 + vt * 32 + l31; float* so = Sout + vt * 32 + l31;
#pragma unroll
        for (int kt = 0; kt < 4; ++kt)
#pragma unroll
            for (int r = 0; r < 16; ++r) S[kt][r] = sp[(size_t)(32 * kt + crow(r, hi)) * HD];
        f32x16 D;
#pragma unroll
        for (int r = 0; r < 16; ++r) D[r] = 0.f;
        D = MFMA32(Xf[0], pack8<0>(S[0]), D); D = MFMA32(Xf[1], pack8<1>(S[0]), D); D = MFMA32(Xf[2], pack8<0>(S[1]), D); D = MFMA32(Xf[3], pack8<1>(S[1]), D);
        D = MFMA32(Xf[4], pack8<0>(S[2]), D); D = MFMA32(Xf[5], pack8<1>(S[2]), D); D = MFMA32(Xf[6], pack8<0>(S[3]), D); D = MFMA32(Xf[7], pack8<1>(S[3]), D);
        float vn[4];
#pragma unroll
        for (int r = 0; r < 4; ++r) vn[r] = U[(4 * hi + r) * 128 + vt * 32 + l31] + D[r];
        u32x4 pv; pv.x = cvtpk(vn[0], vn[1]); pv.y = cvtpk(vn[2], vn[3]); pv.z = 0u; pv.w = 0u; const bf16x8 vf = __builtin_bit_cast(bf16x8, pv);
        D = MFMA32(QKX, vf, D);
#pragma unroll
        for (int kt = 0; kt < 4; ++kt) { S[kt] = S[kt] * al; S[kt] = MFMA32(KDX[kt], vf, S[kt]); }
#pragma unroll
        for (int r = 0; r < 4; ++r) OS[(4 * hi + r) * 132 + vt * 32 + l31] = D[4 + r];
#pragma unroll
        for (int kt = 0; kt < 4; ++kt)
#pragma unroll
            for (int r = 0; r < 16; ++r) so[(size_t)(32 * kt + crow(r, hi)) * HD] = S[kt][r];
    }
    asm volatile("s_waitcnt lgkmcnt(0)" ::: "memory");
    { const int r = lane >> 3, sg = lane & 7; float o[16];
#pragma unroll
      for (int q4 = 0; q4 < 4; ++q4) { const f32x4 t = *(const LAS f32x4*)(OS + r * 132 + sg * 16 + 4 * q4); o[4 * q4] = t[0]; o[4 * q4 + 1] = t[1]; o[4 * q4 + 2] = t[2]; o[4 * q4 + 3] = t[3]; }
      float ss = 0.f;
#pragma unroll
      for (int e = 0; e < 16; ++e) ss += o[e] * o[e];
      ss += swz_xor<1>(ss); ss += swz_xor<2>(ss); ss += swz_xor<4>(ss);
      const float rn = __builtin_amdgcn_rsqf(ss * (1.0f / HD) + RMS_EPS);
      const bf16_t* zp = proj + (size_t)(row0 + r) * PROJ_LD + O2 + h * HD + sg * 16; float z[16]; { float t8[8]; bf8_to_f32(*(const u32x4*)zp, t8);
#pragma unroll
          for (int e = 0; e < 8; ++e) z[e] = t8[e];
          bf8_to_f32(*(const u32x4*)(zp + 8), t8);
#pragma unroll
          for (int e = 0; e < 8; ++e) z[8 + e] = t8[e]; }
      unsigned w[8];
#pragma unroll
      for (int e = 0; e < 16; e += 2) { const float a = o[e] * rn * ong[sg * 16 + e] * (z[e] * fast_sigmoid(z[e])), c = o[e + 1] * rn * ong[sg * 16 + e + 1] * (z[e + 1] * fast_sigmoid(z[e + 1])); w[e >> 1] = pk2(a, c); }
      bf16_t* mp = mixed + (size_t)(row0 + r) * DM + PW + h * HD + sg * 16;
      *(u32x4*)mp = (u32x4){w[0], w[1], w[2], w[3]}; *(u32x4*)(mp + 8) = (u32x4){w[4], w[5], w[6], w[7]}; }
    asm volatile("s_waitcnt lgkmcnt(0)" ::: "memory");
}

constexpr int G1L_QB = 0, G1L_KB = 17408, G1L_KT = 34816, G1L_KGT = 53248, G1L_VBT = 71680, G1L_AT = 90112, G1L_TB = 107520, G1L_TAB = 116736, G1L_TM = 118016  , G1L_MS = 135424  ;
__device__ __forceinline__ f32x16 tile_chain(const LAS bf16_t* A, int lda, const LAS bf16_t* B, int ldb, int nsteps, int l31, int hi) {
    f32x16 acc;
#pragma unroll
    for (int r = 0; r < 16; ++r) acc[r] = 0.f;
#pragma unroll
    for (int s = 0; s < 8; ++s) if (s < nsteps) { const bf16x8 a = *(const LAS bf16x8*)(A + l31 * lda + 16 * s + 8 * hi), b = *(const LAS bf16x8*)(B + l31 * ldb + 16 * s + 8 * hi); acc = MFMA32(a, b, acc); }
    return acc;
}
__device__ __forceinline__ void g1_chunk(const bf16_t* __restrict__ proj, const float* __restrict__ wconv, const float* __restrict__ BAq, const float* __restrict__ alog, const float* __restrict__ dtb,
                                         unsigned char* cb, float* glast_out, int r0, int t0, int h, LAS unsigned char* lds, int wave, int lane, int r0n, int hn) {
    asm volatile("" : "+v"(lds));
    asm volatile("" : "+v"(lane));
    LAS bf16_t* qB = (LAS bf16_t*)(lds + G1L_QB); LAS bf16_t* kB = (LAS bf16_t*)(lds + G1L_KB); LAS bf16_t* kT = (LAS bf16_t*)(lds + G1L_KT);
    LAS bf16_t* kgT = (LAS bf16_t*)(lds + G1L_KGT); LAS bf16_t* vbT = (LAS bf16_t*)(lds + G1L_VBT); LAS float* AT = (LAS float*)(lds + G1L_AT);
    LAS bf16_t* TB = (LAS bf16_t*)(lds + G1L_TB); LAS float* tab = (LAS float*)(lds + G1L_TAB);
    LAS bf16_t* vB = (LAS bf16_t*)(lds + G1L_TM);
    LAS float* wcv = (LAS float*)(lds + G1L_MS);
    LAS float* t_gc = tab; LAS float* t_be = tab + 64; LAS float* t_eg = tab + 128; LAS float* t_ed = tab + 192; LAS float* t_sc = tab + 256;
    const int tid = wave * 64 + lane, l31 = lane & 31, hi = lane >> 5;
    const int row = tid >> 3, seg = tid & 7;
    u32x4 raw[3][4][2];
#pragma unroll
    for (int tn = 0; tn < 3; ++tn)
#pragma unroll
        for (int j = 0; j < 4; ++j) { const int tt = t0 + row - 3 + j;
            raw[tn][j][0] = (u32x4){0u, 0u, 0u, 0u}; raw[tn][j][1] = raw[tn][j][0];
            if (tt >= 0) { const bf16_t* p = proj + (size_t)(r0 + row - 3 + j) * PROJ_LD + O1 + tn * DNW + h * HD + seg * 16; raw[tn][j][0] = *(const u32x4*)p; raw[tn][j][1] = *(const u32x4*)(p + 8); } }
    if (tid < 384) { const int wr_ = tid >> 5, c4 = tid & 31, tn = wr_ >> 2, j = wr_ & 3;
        *(LAS f32x4*)(wcv + wr_ * 128 + c4 * 4) = *(const f32x4*)(wconv + (size_t)j * CCH + tn * DNW + h * HD + c4 * 4); }
    float gq = 0.f, beq = 0.f;
    if (wave == 0) { const float braw = BAq[(size_t)(r0 + lane) * 64 + h], araw = BAq[(size_t)(r0 + lane) * 64 + NH + h]; const float xx = araw + dtb[h];
        gq = -expf(alog[h]) * (fmaxf(xx, 0.f) + log1pf(expf(-fabsf(xx)))); beq = 1.0f / (1.0f + expf(-braw)); }
    __syncthreads();
#pragma unroll
    for (int tn = 0; tn < 3; ++tn) {
        float acc[16];
#pragma unroll
        for (int e = 0; e < 16; ++e) acc[e] = 0.f;
#pragma unroll
        for (int j = 0; j < 4; ++j) { float x0[8], x1[8]; bf8_to_f32(raw[tn][j][0], x0); bf8_to_f32(raw[tn][j][1], x1);
            const LAS f32x4* wp = (const LAS f32x4*)(wcv + (tn * 4 + j) * 128 + seg * 16); const f32x4 w0 = wp[0], w1 = wp[1], w2 = wp[2], w3 = wp[3];
#pragma unroll
            for (int e = 0; e < 4; ++e) { acc[e] += x0[e] * w0[e]; acc[4 + e] += x0[4 + e] * w1[e]; acc[8 + e] += x1[e] * w2[e]; acc[12 + e] += x1[4 + e] * w3[e]; } }
        float ss = 0.f;
#pragma unroll
        for (int e = 0; e < 16; ++e) { acc[e] = acc[e] * fast_sigmoid(acc[e]); ss += acc[e] * acc[e]; }
        if (tn < 2) { ss += swz_xor<1>(ss); ss += swz_xor<2>(ss); ss += swz_xor<4>(ss); float rn = __builtin_amdgcn_rsqf(ss + L2_EPS); if (tn == 0) rn *= 0.08838834764831845f;
#pragma unroll
            for (int e = 0; e < 16; ++e) acc[e] *= rn; }
        u32x4 p0, p1; p0.x = pk2(acc[0], acc[1]); p0.y = pk2(acc[2], acc[3]); p0.z = pk2(acc[4], acc[5]); p0.w = pk2(acc[6], acc[7]);
        p1.x = pk2(acc[8], acc[9]); p1.y = pk2(acc[10], acc[11]); p1.z = pk2(acc[12], acc[13]); p1.w = pk2(acc[14], acc[15]);
        LAS bf16_t* dst = (tn == 0 ? qB : tn == 1 ? kB : vB) + row * 136 + seg * 16;
        *(LAS u32x4*)dst = p0; *(LAS u32x4*)(dst + 8) = p1;
    }
    if (wave == 0) {
        float x = gq; const float be = beq;
        int ls = lane; asm volatile("" : "+v"(ls));
#pragma unroll
        for (int off = 1; off < 64; off <<= 1) { const float y = bperm_f((ls - off) & 63, x); if (ls >= off) x += y; }
        const float gl = bperm_f(63, x);
        const float eg = __expf(x);
        t_gc[lane] = x; t_be[lane] = be; t_eg[lane] = eg; t_ed[lane] = __expf(gl - x); t_sc[lane] = be * eg;
        if (lane == 63) *glast_out = eg;
    }
    __syncthreads();
    unsigned pf0 = 0u, pf1 = 0u, pf2 = 0u;
    if (r0n >= 0) { const unsigned* pp = (const unsigned*)(proj + (size_t)(r0n + row) * PROJ_LD + O1 + hn * HD + seg * 16);
        pf0 = pp[0]; pf1 = pp[DNW / 2]; pf2 = pp[DNW]; }
    { const int tc = tid & 127, rg = tid >> 7;
      unsigned kraw[16], vraw[16];
#pragma unroll
      for (int i = 0; i < 16; ++i) { kraw[i] = kB[(16 * rg + i) * 136 + tc]; vraw[i] = vB[(16 * rg + i) * 136 + tc]; }
      { u32x4 a, b; a.x = kraw[0] | (kraw[1] << 16); a.y = kraw[2] | (kraw[3] << 16); a.z = kraw[4] | (kraw[5] << 16); a.w = kraw[6] | (kraw[7] << 16);
        b.x = kraw[8] | (kraw[9] << 16); b.y = kraw[10] | (kraw[11] << 16); b.z = kraw[12] | (kraw[13] << 16); b.w = kraw[14] | (kraw[15] << 16);
        *(LAS u32x4*)(kT + tc * 72 + rg * 16) = a; *(LAS u32x4*)(kT + tc * 72 + rg * 16 + 8) = b; }
      float kf[16], vf[16];
#pragma unroll
      for (int i = 0; i < 16; ++i) { kf[i] = __builtin_bit_cast(float, kraw[i] << 16) * t_sc[16 * rg + i]; vf[i] = __builtin_bit_cast(float, vraw[i] << 16) * t_be[16 * rg + i]; }
      u32x4 a, b; a.x = cvtpk(kf[0], kf[1]); a.y = cvtpk(kf[2], kf[3]); a.z = cvtpk(kf[4], kf[5]); a.w = cvtpk(kf[6], kf[7]); b.x = cvtpk(kf[8], kf[9]); b.y = cvtpk(kf[10], kf[11]); b.z = cvtpk(kf[12], kf[13]); b.w = cvtpk(kf[14], kf[15]);
      *(LAS u32x4*)(kgT + tc * 72 + rg * 16) = a; *(LAS u32x4*)(kgT + tc * 72 + rg * 16 + 8) = b;
      a.x = cvtpk(vf[0], vf[1]); a.y = cvtpk(vf[2], vf[3]); a.z = cvtpk(vf[4], vf[5]); a.w = cvtpk(vf[6], vf[7]); b.x = cvtpk(vf[8], vf[9]); b.y = cvtpk(vf[10], vf[11]); b.z = cvtpk(vf[12], vf[13]); b.w = cvtpk(vf[14], vf[15]);
      *(LAS u32x4*)(vbT + tc * 72 + rg * 16) = a; *(LAS u32x4*)(vbT + tc * 72 + rg * 16 + 8) = b; }
    __syncthreads();
    if (wave < 3) {
        const int jt = wave == 0 ? 0 : 1, ct = wave == 2 ? 1 : 0;
        const f32x16 D = tile_chain(kB + 32 * jt * 136, 136, kB + 32 * ct * 136, 136, 8, l31, hi);
        const int c = 32 * ct + l31; const float gcc = t_gc[c];
#pragma unroll
        for (int g4 = 0; g4 < 4; ++g4) { const int j0 = 32 * jt + 8 * g4 + 4 * hi; const f32x4 gj = *(const LAS f32x4*)(t_gc + j0), bj = *(const LAS f32x4*)(t_be + j0); f32x4 o;
#pragma unroll
            for (int e = 0; e < 4; ++e) o[e] = (j0 + e > c) ? bj[e] * __expf(gj[e] - gcc) * D[4 * g4 + e] : 0.f;
            *(LAS f32x4*)(AT + c * 68 + j0) = o; }
    } else if (wave < 6) {
        const int jt = wave == 5 ? 1 : 0, it = wave == 3 ? 0 : 1;
        const f32x16 D = tile_chain(kB + 32 * jt * 136, 136, qB + 32 * it * 136, 136, 8, l31, hi);
        const int i = 32 * it + l31; const float gci = t_gc[i]; f32x16 P;
#pragma unroll
        for (int g4 = 0; g4 < 4; ++g4) { const int j0 = 32 * jt + 8 * g4 + 4 * hi; const f32x4 gj = *(const LAS f32x4*)(t_gc + j0);
#pragma unroll
            for (int e = 0; e < 4; ++e) P[4 * g4 + e] = (i >= j0 + e) ? __expf(gci - gj[e]) * D[4 * g4 + e] : 0.f; }
        bf16x8* dst = (bf16x8*)(cb + G1_QKF) + lane;
        dst[(it * 2 + 2 * jt) * 64] = pack8<0>(P); dst[(it * 2 + 2 * jt + 1) * 64] = pack8<1>(P);
    } else if (wave == 6) {
        bf16x8* dst = (bf16x8*)(cb + G1_QGF) + lane;
#pragma unroll
        for (int ct = 0; ct < 2; ++ct) { const int c = 32 * ct + l31; const float eg = t_eg[c];
#pragma unroll
            for (int ks = 0; ks < 8; ++ks) { const int k0 = 32 * (ks >> 1) + 16 * (ks & 1) + 4 * hi; const u32x2 a = *(const LAS u32x2*)(qB + c * 136 + k0), b = *(const LAS u32x2*)(qB + c * 136 + k0 + 8);
                u32x4 p; p.x = cvtpk(bf_lo(a.x) * eg, bf_hi(a.x) * eg); p.y = cvtpk(bf_lo(a.y) * eg, bf_hi(a.y) * eg); p.z = cvtpk(bf_lo(b.x) * eg, bf_hi(b.x) * eg); p.w = cvtpk(bf_lo(b.y) * eg, bf_hi(b.y) * eg);
                dst[(ct * 8 + ks) * 64] = __builtin_bit_cast(bf16x8, p); } }
    } else {
        bf16x8* dst = (bf16x8*)(cb + G1_KDF) + lane;
#pragma unroll
        for (int cs = 0; cs < 4; ++cs) { const int c0 = 32 * (cs >> 1) + 16 * (cs & 1) + 4 * hi; const f32x4 e0 = *(const LAS f32x4*)(t_ed + c0), e1 = *(const LAS f32x4*)(t_ed + c0 + 8);
#pragma unroll
            for (int kt = 0; kt < 4; ++kt) { const int k = 32 * kt + l31; const u32x2 a = *(const LAS u32x2*)(kT + k * 72 + c0), b = *(const LAS u32x2*)(kT + k * 72 + c0 + 8);
                u32x4 p; p.x = cvtpk(bf_lo(a.x) * e0[0], bf_hi(a.x) * e0[1]); p.y = cvtpk(bf_lo(a.y) * e0[2], bf_hi(a.y) * e0[3]); p.z = cvtpk(bf_lo(b.x) * e1[0], bf_hi(b.x) * e1[1]); p.w = cvtpk(bf_lo(b.y) * e1[2], bf_hi(b.y) * e1[3]);
                dst[(kt * 4 + cs) * 64] = __builtin_bit_cast(bf16x8, p); } }
    }
    __syncthreads();
    {
        LAS float* at = AT; asm volatile("" : "+v"(at));
        LAS float* Tm = (LAS float*)(lds + G1L_TM); LAS float* Ms = (LAS float*)(lds + G1L_MS) + wave * 320;
        if (wave == 0) {
            const int bb = lane >> 4, r = lane & 15; int rr = r; asm volatile("" : "+v"(rr));
            const LAS float* ab = at + (16 * bb) * 68 + 16 * bb;
            float T[16];
#pragma unroll
            for (int c = 15; c >= 0; --c) {
                float a0 = (rr == c) ? 1.f : 0.f, a1 = 0.f, a2 = 0.f, a3 = 0.f;
#pragma unroll
                for (int j4 = ((c + 1) & ~3); j4 < 16; j4 += 4) {
                    const f32x4 a4 = *(const LAS f32x4*)(ab + c * 68 + j4);
                    if (j4 + 0 > c) a0 -= T[j4 + 0] * a4[0];
                    if (j4 + 1 > c) a1 -= T[j4 + 1] * a4[1];
                    if (j4 + 2 > c) a2 -= T[j4 + 2] * a4[2];
                    if (j4 + 3 > c) a3 -= T[j4 + 3] * a4[3];
                }
                T[c] = (a0 + a1) + (a2 + a3);
            }
            LAS float* td = Tm + (16 * bb + r) * 68 + 16 * bb;
#pragma unroll
            for (int q = 0; q < 4; ++q) *(LAS f32x4*)(td + 4 * q) = (f32x4){T[4 * q], T[4 * q + 1], T[4 * q + 2], T[4 * q + 3]};
        }
        __syncthreads();
        const int lr = lane & 15, lq = lane >> 4;
#define G1_MM(acc, xp, xsr, xsq, yp, ysq) do { _Pragma("unroll") for (int s_ = 0; s_ < 4; ++s_) { const int q_ = 4 * s_ + lq; \
            acc = __builtin_amdgcn_mfma_f32_16x16x4f32((xp)[lr * (xsr) + q_ * (xsq)], (yp)[q_ * (ysq) + lr], acc, 0, 0, 0); } } while (0)
#pragma unroll
        for (int lev = 1; lev <= 3; ++lev) {
            if (wave < 4 - lev) {
                const int bj = wave, bi = wave + lev;
                f32x4 m = (f32x4){0.f, 0.f, 0.f, 0.f};
#pragma unroll
                for (int dk = 0; dk < 3; ++dk) if (dk < lev) { const int bk = bj + dk;
                    const LAS float* xp = at + (16 * bk) * 68 + 16 * bi; const LAS float* yp = Tm + (16 * bk) * 68 + 16 * bj;
                    G1_MM(m, xp, 1, 68, yp, 68); }
#pragma unroll
                for (int e = 0; e < 4; ++e) Ms[(4 * lq + e) * 20 + lr] = m[e];
                asm volatile("s_waitcnt lgkmcnt(0)" ::: "memory");
                f32x4 t = (f32x4){0.f, 0.f, 0.f, 0.f};
                { const LAS float* xp = Tm + (16 * bi) * 68 + 16 * bi; G1_MM(t, xp, 68, 1, Ms, 20); }
#pragma unroll
                for (int e = 0; e < 4; ++e) Tm[(16 * bi + 4 * lq + e) * 68 + 16 * bj + lr] = -t[e];
            }
            __syncthreads();
        }
#undef G1_MM
        { const int row = tid >> 3, c8 = (tid & 7) * 8; u32x4 p = (u32x4){0u, 0u, 0u, 0u};
          if ((c8 >> 4) <= (row >> 4)) { const f32x4 a = *(const LAS f32x4*)(Tm + row * 68 + c8), b = *(const LAS f32x4*)(Tm + row * 68 + c8 + 4);
              p.x = cvtpk(a[0], a[1]); p.y = cvtpk(a[2], a[3]); p.z = cvtpk(b[0], b[1]); p.w = cvtpk(b[2], b[3]); }
          *(LAS u32x4*)(TB + row * 72 + c8) = p; }
    }
    __syncthreads();
    { const int it = wave >> 2, vt = wave & 3;
      const f32x16 D = tile_chain(TB + 32 * it * 72, 72, vbT + 32 * vt * 72, 72, 4, l31, hi);
      bf16x8* dst = (bf16x8*)(cb + G1_UF) + lane;
      dst[((vt * 2 + it) * 2) * 64] = pack8<0>(D); dst[((vt * 2 + it) * 2 + 1) * 64] = pack8<1>(D); }
    { const int kt = wave >> 1, it = wave & 1;
      f32x16 D = tile_chain(kgT + 32 * kt * 72, 72, TB + 32 * it * 72, 72, 4, l31, hi);
#pragma unroll
      for (int r = 0; r < 16; ++r) D[r] = -D[r];
      bf16x8* dst = (bf16x8*)(cb + G1_WF) + lane;
      dst[(it * 8 + 2 * kt) * 64] = pack8<0>(D); dst[(it * 8 + 2 * kt + 1) * 64] = pack8<1>(D); }
    asm volatile("" :: "v"(pf0), "v"(pf1), "v"(pf2));
    __syncthreads();
}

constexpr int G2_FRAG_BYTES = G1_CHUNK_BYTES, G2_OST = 2 * G2_FRAG_BYTES, G2_OLD = 136;
template <int NP>
__device__ __forceinline__ void g2_load_z(u32x4 (&zz)[NP], const bf16_t* __restrict__ proj, int row0g, int h, int rbase, int lane) {
    const int cg = lane & 15, rs = lane >> 4;
#pragma unroll
    for (int p = 0; p < NP; ++p) { const int r = rbase + 4 * p + rs; zz[p] = *(const u32x4*)(proj + (size_t)(row0g + r) * PROJ_LD + O2 + h * HD + cg * 8); }
}
template <int NP>
__device__ __forceinline__ void g2_norm_rows(const LAS bf16_t* ost, const u32x4 (&zz)[NP], const f32x4 g0, const f32x4 g1, bf16_t* mixed, int row0g, int h, int rbase, int lane) {
    const int cg = lane & 15, rs = lane >> 4;
#pragma unroll
    for (int p = 0; p < NP; ++p) { const int r = rbase + 4 * p + rs;
        float a[8]; bf8_to_f32(*(const LAS u32x4*)(ost + r * G2_OLD + cg * 8), a);
        float ss = (a[0] * a[0] + a[1] * a[1]) + (a[2] * a[2] + a[3] * a[3]) + (a[4] * a[4] + a[5] * a[5]) + (a[6] * a[6] + a[7] * a[7]);
        ss = sum16(ss); const float rn = __builtin_amdgcn_rsqf(ss * (1.0f / HD) + RMS_EPS);
        float z[8]; bf8_to_f32(zz[p], z);
        float o[8] = {a[0] * g0[0], a[1] * g0[1], a[2] * g0[2], a[3] * g0[3], a[4] * g1[0], a[5] * g1[1], a[6] * g1[2], a[7] * g1[3]};
#pragma unroll
        for (int e = 0; e < 8; ++e) o[e] = o[e] * rn * (z[e] * fast_sigmoid(z[e]));
        u32x4 w; w.x = pk2(o[0], o[1]); w.y = pk2(o[2], o[3]); w.z = pk2(o[4], o[5]); w.w = pk2(o[6], o[7]);
        *(u32x4*)(mixed + (size_t)(row0g + r) * DM + PW + h * HD + cg * 8) = w; }
}
__device__ __forceinline__ void g2_wg(const unsigned char* __restrict__ g1o, const float* __restrict__ glast, const bf16_t* __restrict__ proj, const float* __restrict__ ong, bf16_t* mixed, float* Sout,
                                      int bh, LAS unsigned char* lds, int wave, int lane) {
    const int l31 = lane & 31, hi = lane >> 5, b = bh / NH, h = bh % NH;
    const unsigned char* cb0 = g1o + (size_t)(bh * 32) * G1_CHUNK_BYTES;
    LAS bf16_t* ost = (LAS bf16_t*)(lds + G2_OST);
#define G2_BAR() do { asm volatile("" ::: "memory"); __builtin_amdgcn_s_barrier(); asm volatile("" ::: "memory"); } while (0)
#define G2_DMA(srcp, dstp) do { _Pragma("unroll") for (int p_ = 0; p_ < 35; ++p_) { const int piece_ = lw + 2 * p_; \
        __builtin_amdgcn_global_load_lds((const unsigned*)((srcp) + piece_ * 1024), (LAS unsigned*)((dstp) + piece_ * 1024), 16, 0, 0); } } while (0)
    if (wave >= 6) {
        const int nw = 32 + 16 * (wave - 6); const int cg = lane & 15;
        const f32x4 g0 = *(const f32x4*)(ong + cg * 8), g1 = *(const f32x4*)(ong + cg * 8 + 4);
        u32x4 zz[4];
        g2_load_z<4>(zz, proj, b * SEQ, h, nw, lane);
#pragma unroll 1
        for (int n = 0; n < 32; ++n) {
            G2_BAR();
            if (n > 0) { g2_norm_rows<4>(ost, zz, g0, g1, mixed, b * SEQ + (n - 1) * 64, h, nw, lane); g2_load_z<4>(zz, proj, b * SEQ + n * 64, h, nw, lane); }
            asm volatile("s_waitcnt lgkmcnt(0)" ::: "memory");
            G2_BAR();
        }
        G2_BAR();
        g2_norm_rows<4>(ost, zz, g0, g1, mixed, b * SEQ + 31 * 64, h, nw, lane);
        return;
    }
    if (wave >= 4) {
        const int lw = wave - 4; const int nw = 16 * lw; const int cg = lane & 15;
        const f32x4 g0 = *(const f32x4*)(ong + cg * 8), g1 = *(const f32x4*)(ong + cg * 8 + 4);
        u32x4 zz[4];
        { const unsigned char* src = cb0 + lane * 16; G2_DMA(src, lds); }
        g2_load_z<4>(zz, proj, b * SEQ, h, nw, lane);
#pragma unroll 1
        for (int n = 0; n < 32; ++n) {
            asm volatile("s_waitcnt vmcnt(0)" ::: "memory");
#pragma unroll
            for (int p = 0; p < 4; ++p) asm volatile("" : "+v"(zz[p]));
            G2_BAR();
            if (n + 1 < 32) { const unsigned char* src = cb0 + (size_t)(n + 1) * G1_CHUNK_BYTES + lane * 16; LAS unsigned char* dst = lds + ((n + 1) & 1) * G2_FRAG_BYTES; G2_DMA(src, dst); }
            if (n > 0) { g2_norm_rows<4>(ost, zz, g0, g1, mixed, b * SEQ + (n - 1) * 64, h, nw, lane); g2_load_z<4>(zz, proj, b * SEQ + n * 64, h, nw, lane); }
            asm volatile("s_waitcnt lgkmcnt(0)" ::: "memory");
            G2_BAR();
        }
        G2_BAR();
        g2_norm_rows<4>(ost, zz, g0, g1, mixed, b * SEQ + 31 * 64, h, nw, lane);
        return;
    }
    const int vt = wave;
    f32x16 S[4];
#pragma unroll
    for (int kt = 0; kt < 4; ++kt)
#pragma unroll
        for (int r = 0; r < 16; ++r) S[kt][r] = 0.f;
    const float alv = glast[bh * 32 + l31];
    bf16x8 Id[2];
#pragma unroll
    for (int s2 = 0; s2 < 2; ++s2) { u32x4 p;
        unsigned e[8];
#pragma unroll
        for (int j = 0; j < 8; ++j) e[j] = ((16 * s2 + 8 * (j >> 2) + 4 * hi + (j & 3)) == l31) ? 0x3F80u : 0u;
        p.x = e[0] | (e[1] << 16); p.y = e[2] | (e[3] << 16); p.z = e[4] | (e[5] << 16); p.w = e[6] | (e[7] << 16); Id[s2] = __builtin_bit_cast(bf16x8, p); }
#pragma unroll 1
    for (int n = 0; n < 32; ++n) {
        const float al = __builtin_bit_cast(float, __builtin_amdgcn_readlane(__builtin_bit_cast(int, alv), n));
        G2_BAR();
        const LAS bf16x8* F = (const LAS bf16x8*)(lds + (n & 1) * G2_FRAG_BYTES) + lane;
        f32x16 vn[2], o[2];
#pragma unroll
        for (int ct = 0; ct < 2; ++ct)
#pragma unroll
            for (int r = 0; r < 16; ++r) { vn[ct][r] = 0.f; o[ct][r] = 0.f; }
        bf16x8 fq[4]; bf16x8 vb[4]; bf16x8 sbc;
        fq[0] = F[(54 + (vt * 2 + 0) * 2 + 0) * 64];
        fq[1] = F[(54 + (vt * 2 + 0) * 2 + 1) * 64];
        fq[2] = F[(54 + (vt * 2 + 1) * 2 + 0) * 64];
        fq[3] = F[(54 + (vt * 2 + 1) * 2 + 1) * 64];
        __builtin_amdgcn_sched_barrier(0);
        vn[0] = MFMA32(Id[0], fq[0], vn[0]); fq[0] = F[(0) * 64]; __builtin_amdgcn_sched_barrier(0);
        vn[0] = MFMA32(Id[1], fq[1], vn[0]); fq[1] = F[(16) * 64]; __builtin_amdgcn_sched_barrier(0);
        vn[1] = MFMA32(Id[0], fq[2], vn[1]); fq[2] = F[(8) * 64]; __builtin_amdgcn_sched_barrier(0);
        vn[1] = MFMA32(Id[1], fq[3], vn[1]); fq[3] = F[(24) * 64]; __builtin_amdgcn_sched_barrier(0);
        sbc = pack8<0>(S[0]);
        vn[0] = MFMA32(fq[0], sbc, vn[0]); fq[0] = F[(1) * 64]; __builtin_amdgcn_sched_barrier(0);
        o[0] = MFMA32(fq[1], sbc, o[0]); fq[1] = F[(17) * 64]; __builtin_amdgcn_sched_barrier(0); asm volatile("" : "+v"(vn[0]), "+v"(o[0]));
        vn[1] = MFMA32(fq[2], sbc, vn[1]); fq[2] = F[(9) * 64]; __builtin_amdgcn_sched_barrier(0);
        o[1] = MFMA32(fq[3], sbc, o[1]); fq[3] = F[(25) * 64]; __builtin_amdgcn_sched_barrier(0); asm volatile("" : "+v"(vn[1]), "+v"(o[1]));
        sbc = pack8<1>(S[0]);
        vn[0] = MFMA32(fq[0], sbc, vn[0]); fq[0] = F[(2) * 64]; __builtin_amdgcn_sched_barrier(0);
        o[0] = MFMA32(fq[1], sbc, o[0]); fq[1] = F[(18) * 64]; __builtin_amdgcn_sched_barrier(0); asm volatile("" : "+v"(vn[0]), "+v"(o[0]));
        vn[1] = MFMA32(fq[2], sbc, vn[1]); fq[2] = F[(10) * 64]; __builtin_amdgcn_sched_barrier(0);
        o[1] = MFMA32(fq[3], sbc, o[1]); fq[3] = F[(26) * 64]; __builtin_amdgcn_sched_barrier(0); asm volatile("" : "+v"(vn[1]), "+v"(o[1]));
        sbc = pack8<0>(S[1]);
        vn[0] = MFMA32(fq[0], sbc, vn[0]); fq[0] = F[(3) * 64]; __builtin_amdgcn_sched_barrier(0);
        o[0] = MFMA32(fq[1], sbc, o[0]); fq[1] = F[(19) * 64]; __builtin_amdgcn_sched_barrier(0); asm volatile("" : "+v"(vn[0]), "+v"(o[0]));
        vn[1] = MFMA32(fq[2], sbc, vn[1]); fq[2] = F[(11) * 64]; __builtin_amdgcn_sched_barrier(0);
        o[1] = MFMA32(fq[3], sbc, o[1]); fq[3] = F[(27) * 64]; __builtin_amdgcn_sched_barrier(0); asm volatile("" : "+v"(vn[1]), "+v"(o[1]));
        sbc = pack8<1>(S[1]);
        vn[0] = MFMA32(fq[0], sbc, vn[0]); fq[0] = F[(4) * 64]; __builtin_amdgcn_sched_barrier(0);
        o[0] = MFMA32(fq[1], sbc, o[0]); fq[1] = F[(20) * 64]; __builtin_amdgcn_sched_barrier(0); asm volatile("" : "+v"(vn[0]), "+v"(o[0]));
        vn[1] = MFMA32(fq[2], sbc, vn[1]); fq[2] = F[(12) * 64]; __builtin_amdgcn_sched_barrier(0);
        o[1] = MFMA32(fq[3], sbc, o[1]); fq[3] = F[(28) * 64]; __builtin_amdgcn_sched_barrier(0); asm volatile("" : "+v"(vn[1]), "+v"(o[1]));
        sbc = pack8<0>(S[2]);
        vn[0] = MFMA32(fq[0], sbc, vn[0]); fq[0] = F[(5) * 64]; __builtin_amdgcn_sched_barrier(0);
        o[0] = MFMA32(fq[1], sbc, o[0]); fq[1] = F[(21) * 64]; __builtin_amdgcn_sched_barrier(0); asm volatile("" : "+v"(vn[0]), "+v"(o[0]));
        vn[1] = MFMA32(fq[2], sbc, vn[1]); fq[2] = F[(13) * 64]; __builtin_amdgcn_sched_barrier(0);
        o[1] = MFMA32(fq[3], sbc, o[1]); fq[3] = F[(29) * 64]; __builtin_amdgcn_sched_barrier(0); asm volatile("" : "+v"(vn[1]), "+v"(o[1]));
        sbc = pack8<1>(S[2]);
        vn[0] = MFMA32(fq[0], sbc, vn[0]); fq[0] = F[(6) * 64]; __builtin_amdgcn_sched_barrier(0);
        o[0] = MFMA32(fq[1], sbc, o[0]); fq[1] = F[(22) * 64]; __builtin_amdgcn_sched_barrier(0); asm volatile("" : "+v"(vn[0]), "+v"(o[0]));
        vn[1] = MFMA32(fq[2], sbc, vn[1]); fq[2] = F[(14) * 64]; __builtin_amdgcn_sched_barrier(0);
        o[1] = MFMA32(fq[3], sbc, o[1]); fq[3] = F[(30) * 64]; __builtin_amdgcn_sched_barrier(0); asm volatile("" : "+v"(vn[1]), "+v"(o[1]));
        sbc = pack8<0>(S[3]);
        vn[0] = MFMA32(fq[0], sbc, vn[0]); fq[0] = F[(7) * 64]; __builtin_amdgcn_sched_barrier(0);
        o[0] = MFMA32(fq[1], sbc, o[0]); fq[1] = F[(23) * 64]; __builtin_amdgcn_sched_barrier(0); asm volatile("" : "+v"(vn[0]), "+v"(o[0]));
        vn[1] = MFMA32(fq[2], sbc, vn[1]); fq[2] = F[(15) * 64]; __builtin_amdgcn_sched_barrier(0);
        o[1] = MFMA32(fq[3], sbc, o[1]); fq[3] = F[(31) * 64]; __builtin_amdgcn_sched_barrier(0); asm volatile("" : "+v"(vn[1]), "+v"(o[1]));
        sbc = pack8<1>(S[3]);
        vn[0] = MFMA32(fq[0], sbc, vn[0]); fq[0] = F[(32) * 64]; __builtin_amdgcn_sched_barrier(0);
        o[0] = MFMA32(fq[1], sbc, o[0]); fq[1] = F[(34) * 64]; __builtin_amdgcn_sched_barrier(0); asm volatile("" : "+v"(vn[0]), "+v"(o[0]));
        vn[1] = MFMA32(fq[2], sbc, vn[1]); fq[2] = F[(38) * 64]; __builtin_amdgcn_sched_barrier(0);
        o[1] = MFMA32(fq[3], sbc, o[1]); fq[3] = F[(42) * 64]; __builtin_amdgcn_sched_barrier(0); asm volatile("" : "+v"(vn[1]), "+v"(o[1]));
        vb[0] = pack8<0>(vn[0]); vb[1] = pack8<1>(vn[0]); vb[2] = pack8<0>(vn[1]); vb[3] = pack8<1>(vn[1]);
#pragma unroll
        for (int kt = 0; kt < 4; ++kt) S[kt] = S[kt] * al;
        __builtin_amdgcn_sched_barrier(0);
        o[0] = MFMA32(fq[0], vb[0], o[0]); fq[0] = F[(46) * 64]; __builtin_amdgcn_sched_barrier(0);
        o[1] = MFMA32(fq[1], vb[0], o[1]); fq[1] = F[(50) * 64]; __builtin_amdgcn_sched_barrier(0);
        S[0] = MFMA32(fq[2], vb[0], S[0]); fq[2] = F[(33) * 64]; __builtin_amdgcn_sched_barrier(0);
        S[1] = MFMA32(fq[3], vb[0], S[1]); fq[3] = F[(35) * 64]; __builtin_amdgcn_sched_barrier(0);
        S[2] = MFMA32(fq[0], vb[0], S[2]); fq[0] = F[(39) * 64]; __builtin_amdgcn_sched_barrier(0);
        S[3] = MFMA32(fq[1], vb[0], S[3]); fq[1] = F[(43) * 64]; __builtin_amdgcn_sched_barrier(0);
        o[0] = MFMA32(fq[2], vb[1], o[0]); fq[2] = F[(47) * 64]; __builtin_amdgcn_sched_barrier(0);
        o[1] = MFMA32(fq[3], vb[1], o[1]); fq[3] = F[(51) * 64]; __builtin_amdgcn_sched_barrier(0);
        S[0] = MFMA32(fq[0], vb[1], S[0]); fq[0] = F[(36) * 64]; __builtin_amdgcn_sched_barrier(0);
        S[1] = MFMA32(fq[1], vb[1], S[1]); fq[1] = F[(40) * 64]; __builtin_amdgcn_sched_barrier(0);
        S[2] = MFMA32(fq[2], vb[1], S[2]); fq[2] = F[(44) * 64]; __builtin_amdgcn_sched_barrier(0);
        S[3] = MFMA32(fq[3], vb[1], S[3]); fq[3] = F[(48) * 64]; __builtin_amdgcn_sched_barrier(0);
        o[1] = MFMA32(fq[0], vb[2], o[1]); fq[0] = F[(52) * 64]; __builtin_amdgcn_sched_barrier(0);
        S[0] = MFMA32(fq[1], vb[2], S[0]); fq[1] = F[(37) * 64]; __builtin_amdgcn_sched_barrier(0);
        S[1] = MFMA32(fq[2], vb[2], S[1]); fq[2] = F[(41) * 64]; __builtin_amdgcn_sched_barrier(0);
        S[2] = MFMA32(fq[3], vb[2], S[2]); fq[3] = F[(45) * 64]; __builtin_amdgcn_sched_barrier(0);
        S[3] = MFMA32(fq[0], vb[2], S[3]); fq[0] = F[(49) * 64]; __builtin_amdgcn_sched_barrier(0);
        o[1] = MFMA32(fq[1], vb[3], o[1]); fq[1] = F[(53) * 64]; __builtin_amdgcn_sched_barrier(0);
        S[0] = MFMA32(fq[2], vb[3], S[0]); __builtin_amdgcn_sched_barrier(0);
        S[1] = MFMA32(fq[3], vb[3], S[1]); __builtin_amdgcn_sched_barrier(0);
        S[2] = MFMA32(fq[0], vb[3], S[2]); __builtin_amdgcn_sched_barrier(0);
        S[3] = MFMA32(fq[1], vb[3], S[3]); __builtin_amdgcn_sched_barrier(0);
        asm volatile("s_waitcnt lgkmcnt(0)" ::: "memory");
        G2_BAR();
#pragma unroll
        for (int ct = 0; ct < 2; ++ct)
#pragma unroll
            for (int r = 0; r < 16; ++r) ost[(32 * ct + crow(r, hi)) * G2_OLD + vt * 32 + l31] = (bf16_t)(cvtpk(o[ct][r], 0.f) & 0xffffu);
        asm volatile("s_waitcnt lgkmcnt(0)" ::: "memory");
    }
    G2_BAR();
#pragma unroll
    for (int kt = 0; kt < 4; ++kt)
#pragma unroll
        for (int r = 0; r < 16; ++r) Sout[(size_t)(32 * kt + crow(r, hi)) * HD + vt * 32 + l31] = S[kt][r];
#undef G2_BAR
#undef G2_DMA
}

#ifndef PHASE_MASK
#define PHASE_MASK 0xfff
#endif
#define PH(k) (((PHASE_MASK) >> (k)) & 1)
#ifndef DUP_MASK
#define DUP_MASK 0
#endif
#define REP(k) for (int rep_ = 0; rep_ < ((((DUP_MASK) >> (k)) & 1) + 1); ++rep_)
__global__ void __launch_bounds__(NWAVES * 64, 2) hymba_fwd(Args args) {
    extern __shared__ __attribute__((aligned(16))) unsigned char lds_raw[];
    LAS unsigned char* lds = (LAS unsigned char*)lds_raw;
    volatile LAS unsigned* MISC = (volatile LAS unsigned*)(lds + MISC_OFF);
    const int wave = __builtin_amdgcn_readfirstlane((int)threadIdx.x >> 6);
    const int G = gridDim.x, bx = blockIdx.x;
    const int vcu = (G % 8 == 0) ? (bx % 8) * (G / 8) + bx / 8 : bx;
    const int gw = vcu * NWAVES + wave, NGW = G * NWAVES;
    typedef const __attribute__((address_space(4))) Args* KArgs;
#define KARGS() ({ KArgs _p = (KArgs)__builtin_amdgcn_kernarg_segment_ptr(); asm volatile("" : "+s"(_p)); _p; })
#define WSP(T, off) ((T*)(ap->ws + (off)))
#define CF(off) ((float*)(ap->ws + WS_CTL + (off)))
#define x_prompt (ap->in[0])
#define x_sample (ap->in[1])
#define state_pool (ap->in[2])
#define state_conv (ap->in[3])
#define state_delta (ap->in[4])
#define p_prompt (ap->in[5])
#define p_sample (ap->in[6])
#define w_in (ap->in[7])
#define w_pool (ap->in[8])
#define pool_scale (ap->in[9])
#define w_conv (ap->in[10])
#define a_log (ap->in[11])
#define dt_bias (ap->in[12])
#define o_norm_g (ap->in[13])
#define w_out (ap->in[14])
#define ln1_g (ap->in[15])
#define ln1_b (ap->in[16])
#define w_gate_up (ap->in[17])
#define w_down (ap->in[18])
#define ln2_g (ap->in[19])
#define ln2_b (ap->in[20])
#define w_ple_gate (ap->in[21])
#define w_ple_proj (ap->in[22])
#define out (ap->out)
#define WIN WSP(bf16_t, WS_WIN)
#define WOUT WSP(bf16_t, WS_WOUT)
#define WGU WSP(bf16_t, WS_WGU)
#define WDN WSP(bf16_t, WS_WDN)
#define WPG WSP(bf16_t, WS_WPG)
#define WPP WSP(bf16_t, WS_WPP)
#define WPOOL WSP(bf16_t, WS_WPOOL)
#define XB WSP(bf16_t, WS_XB)
#define PB WSP(bf16_t, WS_PB)
#define PROJ WSP(bf16_t, WS_PROJ)
#define BA WSP(float, WS_BA)
#define DPOOL WSP(bf16_t, WS_DPOOL)
#define MIXED WSP(bf16_t, WS_MIXED)
#define QN WSP(bf16_t, WS_QN)
#define KN WSP(bf16_t, WS_KN)
#define VC WSP(bf16_t, WS_VC)
#define GLp WSP(float, WS_GL)
#define GLASTp WSP(float, WS_GLAST)
#define G1O WSP(unsigned char, WS_G1)
#define SLAB WSP(float, WS_SLAB)
#define SLAB2 WSP(float, WS_G1)
#define CPART WSP(float, WS_CPART)
#define PST WSP(float, WS_PST)
#define GAp WSP(float, WS_GA)
#define GBp WSP(float, WS_GB)
#define OB WSP(float, WS_O)
#define HF WSP(float, WS_H)
#define HB WSP(bf16_t, WS_HB)
#define EB WSP(bf16_t, WS_E)
#define ACT WSP(bf16_t, WS_ACT)
#define H2B WSP(bf16_t, WS_H2B)
#define H2B8 WSP(unsigned char, WS_H2B8)
#define HB8I WSP(unsigned char, WS_H2B8)
    unsigned* ctl = (unsigned*)(args.ws + WS_CTL);

    for (int u = threadIdx.x; u < (LDS_BYTES - LDSCTL_OFF) / 4; u += NWAVES * 64) ((LAS unsigned*)(lds + LDSCTL_OFF))[u] = 0u;
    __syncthreads();
    XcdBarrier bar = xcd_barrier_post(ctl + CW_BAR, MISC + 8);

    REP(0) if (PH(0))
    {
        KArgs ap = KARGS();
        int lane_ = lane_id(); asm volatile("" : "+v"(lane_)); const int lane = lane_, tid = wave * 64 + lane; (void)tid;
        LAS float* scr = (LAS float*)(lds + wave * 16384);
        constexpr int I_IN = (DM / 64) * ((PROJ_OUT + 31) / 32), I_SQ = (DM / 64) * (DM / 32), I_GU = (DM / 64) * (2 * DFF / 32), I_DN = (DFF / 64) * (DM / 32),
                      I_PP = (PLE / 64) * (DM / 32), I_PL = 4 * (256 / 64) * (256 / 32);
        constexpr int NITEMS = I_IN + 2 * I_SQ + I_GU + I_DN + I_PP + I_PL;
        for (int it = gw; it < NITEMS; it += NGW) {
            int r = it;
            if (r < I_IN) { transpose_item<0>(w_in, DM, PROJ_OUT, WIN, scr, r, lane); continue; } r -= I_IN;
            if (r < I_SQ) { transpose_item<0>(w_out, DM, DM, WOUT, scr, r, lane); continue; } r -= I_SQ;
            if (r < I_SQ) { transpose_item<0, 1, 64>(w_ple_gate, DM, DM, WPG, scr, r, lane, ln2_g, ln2_b, CPART + 2 * DFF, CPART + (size_t)64 * CP_N + 2 * DFF); continue; } r -= I_SQ;
            if (r < I_GU) { transpose_item<1, 1, 0, 1>(w_gate_up, DM, 2 * DFF, WGU, scr, r, lane, ln1_g, ln1_b, CPART, CPART + (size_t)64 * CP_N); continue; } r -= I_GU;
            if (r < I_DN) { transpose_item<0, 0, WDN8_SCALE>(w_down, DFF, DM, WDN, scr, r, lane); continue; } r -= I_DN;
            if (r < I_PP) { transpose_item<0>(w_ple_proj, PLE, DM, WPP, scr, r, lane); continue; } r -= I_PP;
            { const int grp = r / 32; transpose_item<0>(w_pool + (size_t)grp * 65536, 256, 256, WPOOL + (size_t)grp * 65536, scr, r % 32, lane); }
        }
        { u32x4* z = (u32x4*)(WIN + (size_t)13376 * DM); const int n16 = (PROJ_PAD - 13376) * DM * 2 / 16;
          for (int i = bx * 512 + tid; i < n16; i += G * 512) z[i] = (u32x4){0u, 0u, 0u, 0u}; }
        for (int m = gw; m < M; m += NGW) {
            const f32x4* src = (const f32x4*)(m < MP ? x_prompt + (size_t)m * DM : x_sample + (size_t)(m - MP) * DM) + lane;
            u32x2* dst = (u32x2*)(XB + (size_t)m * DM) + lane;
#pragma unroll
            for (int j = 0; j < 16; ++j) { const f32x4 v = src[64 * j]; u32x2 w; w.x = pk2(v.x, v.y); w.y = pk2(v.z, v.w); dst[64 * j] = w; }
        }
        for (int m = gw; m < M; m += NGW) {
            const f32x4 v = ((const f32x4*)(m < MP ? p_prompt + (size_t)m * PLE : p_sample + (size_t)(m - MP) * PLE))[lane];
            u32x2 w; w.x = pk2(v.x, v.y); w.y = pk2(v.z, v.w); ((u32x2*)(PB + (size_t)m * PLE))[lane] = w;
        }
        for (int i = bx * 512 + tid; i < DB * 7 * (PW / 4); i += G * 512) {
            const int c4 = i % (PW / 4), r = (i / (PW / 4)) % 7, b = i / (7 * (PW / 4));
            ((f32x4*)(out + OUT_NPS + ((size_t)(b * 15 + r)) * PW))[c4] = ((const f32x4*)(state_pool + ((size_t)(b * 15 + 8 + r)) * PW))[c4];
        }
    }
    xcd_barrier(bar);

    REP(1) if (PH(1))
    {
        KArgs ap = KARGS();
        int lane_ = lane_id(); asm volatile("" : "+v"(lane_)); const int lane = lane_, tid = wave * 64 + lane; (void)tid;
        pg8::Gemm g{XB, WIN, M, PROJ_PAD, DM, DM, DM, 0}; pg8::StaticOrder S; S.init(M, PROJ_PAD, DM, G, bx);
        pg8::EpiProj E{PROJ, BA, out};
        pg8::gemm_phase<pg8::EpiProj>(lds, g, S, E, wave);
        if (G == 256 && bx >= 116) { pg8::Gemm g2{PB, WPP, M, DM, PLE, PLE, PLE, 0}; pg8::StaticOrder S2; S2.init(M, DM, PLE, 140, bx - 116);
            pg8::EpiBf16S E2{EB, DM, nullptr};
            pg8::gemm_phase<pg8::EpiBf16S>(lds, g2, S2, E2, wave); }
    }
    xcd_barrier(bar);

    REP(2) if (PH(2))
    {
        KArgs ap = KARGS();
        int lane_ = lane_id(); asm volatile("" : "+v"(lane_)); const int lane = lane_, tid = wave * 64 + lane; (void)tid;
        unsigned wf0 = 0u, wf1 = 0u, wf2 = 0u;
        if (vcu < NB * NH * 32) { const int bh0 = vcu >> 5; const unsigned* pp = (const unsigned*)(PROJ + (size_t)((bh0 / NH) * SEQ + (vcu & 31) * 64 + (tid >> 3)) * PROJ_LD + O1 + (bh0 % NH) * HD + (tid & 7) * 16);
            wf0 = pp[0]; wf1 = pp[DNW / 2]; wf2 = pp[DNW]; }
        for (int it = bx * 512 + tid; it < (M / 8) * 128; it += G * 512) {
            const int blk = it >> 7, cg = it & 127, grp = cg >> 5, w = 2 << grp;
            const int row0 = blk * 8; const bool sample = row0 >= MP;
            const int b = sample ? (row0 - MP) >> 3 : row0 >> 11, t0 = sample ? 0 : (row0 & 2047);
            u32x4 xb[8]; u32x4 hb[15]; f32x4 hs0[15], hs1[15];
#pragma unroll
            for (int r = 0; r < 8; ++r) xb[r] = *(const u32x4*)(PROJ + (size_t)(row0 + r) * PROJ_LD + cg * 8);
#pragma unroll
            for (int j = 1; j <= 15; ++j) {
                hb[j - 1] = (u32x4){0u, 0u, 0u, 0u}; hs0[j - 1] = (f32x4){0.f, 0.f, 0.f, 0.f}; hs1[j - 1] = hs0[j - 1];
                if (j < w) {
                    if (sample) { const float* sp = state_pool + ((size_t)(b * 15 + 15 - j)) * PW + cg * 8; hs0[j - 1] = *(const f32x4*)sp; hs1[j - 1] = *(const f32x4*)(sp + 4); }
                    else if (t0 - j >= 0) hb[j - 1] = *(const u32x4*)(PROJ + (size_t)(row0 - j) * PROJ_LD + cg * 8);
                }
            }
            float x[8][8], hl[15][8];
#pragma unroll
            for (int r = 0; r < 8; ++r) bf8_to_f32(xb[r], x[r]);
#pragma unroll
            for (int j = 0; j < 15; ++j) { bf8_to_f32(hb[j], hl[j]);
#pragma unroll
                for (int e = 0; e < 4; ++e) { hl[j][e] += hs0[j][e]; hl[j][4 + e] += hs1[j][e]; } }
#pragma unroll
            for (int r = 0; r < 8; ++r) {
                float sm[8];
#pragma unroll
                for (int e = 0; e < 8; ++e) sm[e] = x[r][e];
#pragma unroll
                for (int j = 1; j <= 15; ++j) if (j < w) {
#pragma unroll
                    for (int e = 0; e < 8; ++e) sm[e] += (r - j >= 0) ? x[(r - j >= 0) ? r - j : 0][e] : hl[(j - r - 1 >= 0) ? j - r - 1 : 0][e]; }
                const int t = t0 + r; const float cnt = sample ? (float)w : (float)((t + 1) < w ? (t + 1) : w); const float inv = 1.0f / cnt;
                u32x4 o; o.x = pk2(sm[0] * inv - x[r][0], sm[1] * inv - x[r][1]); o.y = pk2(sm[2] * inv - x[r][2], sm[3] * inv - x[r][3]);
                o.z = pk2(sm[4] * inv - x[r][4], sm[5] * inv - x[r][5]); o.w = pk2(sm[6] * inv - x[r][6], sm[7] * inv - x[r][7]);
                *(u32x4*)(DPOOL + (size_t)(row0 + r) * PW + cg * 8) = o;
            }
        }
        for (int n = G * 512 - 1 - (bx * 512 + tid); n < 2 * CP_N; n += G * 512) { const int which = n / CP_N, col = n % CP_N; const float* p = CPART + (size_t)which * 64 * CP_N + col;
            float pv[64];
#pragma unroll
            for (int kb = 0; kb < 64; ++kb) pv[kb] = p[(size_t)kb * CP_N];
            float a = 0.f;
#pragma unroll
            for (int kb = 0; kb < 64; ++kb) a += pv[kb];
            float* dst = col < 2 * DFF ? CF(which ? CTL_C2GU : CTL_C1GU) + col : CF(which ? CTL_C2PG : CTL_C1PG) + (col - 2 * DFF);
            *dst = a; }
        asm volatile("" :: "v"(wf0), "v"(wf1), "v"(wf2));
#pragma unroll 1
        for (int ci = vcu; ci < NB * NH * 32; ci += G) {
            const int bh = ci >> 5, n = ci & 31, b = bh / NH, h = bh % NH;
            const int cin = ci + G, bhn = cin >> 5, hn_ = bhn % NH, r0n_ = cin < NB * NH * 32 ? (bhn / NH) * SEQ + (cin & 31) * 64 : -1;
            g1_chunk(PROJ, w_conv, BA, a_log, dt_bias, G1O + (size_t)ci * G1_CHUNK_BYTES, GLASTp + ci, b * SEQ + n * 64, n * 64, h, lds, wave, lane, r0n_, hn_);
        }
    }
    xcd_barrier(bar);

    REP(11) if (PH(11))
    {
        KArgs ap = KARGS();
        int lane_ = lane_id(); asm volatile("" : "+v"(lane_)); const int lane = lane_;
        if (vcu < NB * NH) {
            g2_wg(G1O, GLASTp, PROJ, o_norm_g, MIXED, out + OUT_NDP + (size_t)vcu * HD * HD, vcu, lds, wave, lane);
        } else {
            const int gsub = G - NB * NH, csub = vcu - NB * NH;
            const int n3 = ((DB * NH) % (gsub * NWAVES)) / NWAVES, gpool = (n3 > 0 && gsub - n3 >= 64) ? gsub - n3 : gsub, cpool = (gpool == gsub) ? csub : csub - n3;
            if (cpool >= 0) { pg8::Gemm g{DPOOL, WPOOL, M, PW, 256, PW, 256, 256}; pg8::StaticOrder S; S.init(M, PW, 256, gpool, cpool);
              pg8::EpiBf16S E{MIXED, DM, pool_scale};
              pg8::gemm_phase<pg8::EpiBf16S>(lds, g, S, E, wave); }
            if (G != 256) { pg8::Gemm g{PB, WPP, M, DM, PLE, PLE, PLE, 0}; pg8::StaticOrder S; S.init(M, DM, PLE, gsub, csub);
              pg8::EpiBf16S E{EB, DM, nullptr};
              pg8::gemm_phase<pg8::EpiBf16S>(lds, g, S, E, wave); }
            LAS unsigned char* wl = lds + wave * SL_BYTES;
            const int nscan = NB * NH;
            const int myidx = (vcu - nscan) * 8 + wave;
            const int nshort = (G - nscan) * NWAVES;
            for (int it = myidx; it < DB * NH; it += nshort) {
                const int b = it / NH, h = it % NH;
                sample_task(w_conv, state_conv, b, BA, a_log, dt_bias, state_delta + (size_t)it * HD * HD, out + OUT_NDS + (size_t)it * HD * HD, PROJ, o_norm_g, MIXED, MP + b * DS, h, wl, lane);
            }
        }
    }
    xcd_barrier(bar);

    REP(5) if (PH(5))
    {
        KArgs ap = KARGS();
        int lane_ = lane_id(); asm volatile("" : "+v"(lane_)); const int lane = lane_, tid = wave * 64 + lane; (void)tid;
        pg8::Gemm g{MIXED, WOUT, M, DM, DM, DM, DM, 0}; pg8::SplitOrder S; S.init(DM, DM, G, bx);
        pg8::EpiLNRes<0> E{nullptr, XB, HB, PST, SLAB, nullptr, nullptr, nullptr, HB8I};
        pg8::gemm_phase<pg8::EpiLNRes<0>, pg8::SplitOrder>(lds, g, S, E, wave);
    }
    xcd_barrier(bar);

    REP(7) if (PH(7))
    {
        KArgs ap = KARGS();
        int lane_ = lane_id(); asm volatile("" : "+v"(lane_)); const int lane = lane_, tid = wave * 64 + lane; (void)tid;
        rows_pass<0>(x_sample, SLAB, out + OUT_Y, HB, PST, CF(CTL_ST1), nullptr, nullptr, nullptr, (unsigned*)(ap->ws) + CW_ROWS1, vcu, G, wave, lane, HB8I);
        pg8::Gemm g{(const bf16_t*)HB8I, WGU, M, 2 * DFF, DM / 2, DM / 2, DM / 2, 0, (const unsigned*)(ap->ws) + CW_ROWS1, (unsigned)G, true}; pg8::GUOrder S; S.init(G, bx, DM / 2);
        pg8::EpiSwiGLULN E{ACT, CF(CTL_ST1), CF(CTL_C1GU), CF(CTL_C2GU), SLAB2, GU8I_SCALE};
        pg8::gemm_phase<pg8::EpiSwiGLULN, pg8::GUOrder, true, 2>(lds, g, S, E, wave);
    }
    xcd_barrier(bar);

    REP(8) if (PH(8))
    {
        KArgs ap = KARGS();
        int lane_ = lane_id(); asm volatile("" : "+v"(lane_)); const int lane = lane_, tid = wave * 64 + lane; (void)tid;
        if (G == 256 && bx < pg8::GU_LEFT * 8) {
            const int t = bx % pg8::GU_LEFT, j = bx / pg8::GU_LEFT, sel = wave;
            const f32x4* sp = (const f32x4*)SLAB2 + ((size_t)(t * 8) * 8 + j) * 32 * 64 + lane;
            f32x4 val[2][2];
#pragma unroll
            for (int bj = 0; bj < 2; ++bj)
#pragma unroll
                for (int n = 0; n < 2; ++n) { const int q = (((sel >> 2) * 2 + bj) * 4 + (sel & 3)) * 2 + n; f32x4 a = sp[q * 64];
#pragma unroll
                    for (int sl = 1; sl < 8; ++sl) a += sp[(size_t)sl * 8 * 32 * 64 + q * 64];
                    val[bj][n] = a; }
            pg8::f32x4_acc_t acc;
#pragma unroll
            for (int ai = 0; ai < 2; ++ai)
#pragma unroll
                for (int bj = 0; bj < 2; ++bj)
#pragma unroll
                    for (int m = 0; m < 4; ++m)
#pragma unroll
                        for (int n = 0; n < 2; ++n) acc.v[ai][bj][m][n] = (ai * 4 + m == sel) ? val[bj][n] : (f32x4){0.f, 0.f, 0.f, 0.f};
            pg8::Unit u{35, pg8::GU_LEFT_PN0 + t, 0, DM / 64, -1, 0};
            pg8::EpiSwiGLULN E{ACT, CF(CTL_ST1), CF(CTL_C1GU), CF(CTL_C2GU), nullptr, 0.f, sel, true};
            E(acc.v, u, j >> 2, j & 3, lane & 15, lane >> 4);
            asm volatile("s_waitcnt vmcnt(0)" ::: "memory"); __syncthreads();
            if (wave == 0 && lane == 0) __hip_atomic_fetch_add((unsigned*)(ap->ws) + 9200, 1u, __ATOMIC_RELAXED, __HIP_MEMORY_SCOPE_AGENT);
        }
        pg8::Gemm g{ACT, WDN, M, DM, DFF / 2, DFF / 2, DFF / 2, 0, (G == 256) ? (const unsigned*)(ap->ws) + 9200 : nullptr, (unsigned)(pg8::GU_LEFT * 8)}; pg8::SplitOrder S; S.init(DM, DFF / 2, G, bx);
        pg8::EpiLNRes<1> E{nullptr, HB, H2B, PST, SLAB, CF(CTL_ST1), ln1_g, ln1_b, H2B8, DN8_INV};
        pg8::gemm_phase<pg8::EpiLNRes<1>, pg8::SplitOrder, true, true>(lds, g, S, E, wave);
    }
    xcd_barrier(bar);

    REP(10) if (PH(10))
    {
        KArgs ap = KARGS();
        int lane_ = lane_id(); asm volatile("" : "+v"(lane_)); const int lane = lane_, tid = wave * 64 + lane; (void)tid;
        rows_pass<1>(nullptr, SLAB, out + OUT_Y, H2B, PST, CF(CTL_ST2), CF(CTL_ST1), ln1_g, ln1_b, (unsigned*)(ap->ws) + CW_ROWS2, vcu, G, wave, lane, H2B8, DN8_INV);
        pg8::Gemm g{(const bf16_t*)H2B8, WPG, M, DM, DM / 2, DM / 2, DM / 2, 0, (const unsigned*)(ap->ws) + CW_ROWS2, (unsigned)G, true}; pg8::SplitOrder S; S.init(DM, DM / 2, G, bx);
        pg8::EpiFinalLN E{out + OUT_Y, H2B, EB, SLAB, CF(CTL_ST2), CF(CTL_C1PG), CF(CTL_C2PG), ln2_g, ln2_b};
        pg8::gemm_phase<pg8::EpiFinalLN, pg8::SplitOrder, true, true>(lds, g, S, E, wave);
    }
    xcd_barrier(bar);
    {
        KArgs ap = KARGS();
        int lane_ = lane_id(); asm volatile("" : "+v"(lane_)); const int tid = wave * 64 + lane_;
        const f32x4* p0 = (const f32x4*)SLAB; const size_t sl = (size_t)MS * DM / 4;
        f32x4* Y = (f32x4*)(out + OUT_Y + (size_t)MP * DM); const u32x2* Eb = (const u32x2*)(EB + (size_t)MP * DM);
        const float* ST2 = CF(CTL_ST2); const f32x4* c1 = (const f32x4*)CF(CTL_C1PG); const f32x4* c2 = (const f32x4*)CF(CTL_C2PG); const f32x4* g2 = (const f32x4*)ln2_g; const f32x4* b2 = (const f32x4*)ln2_b;
        for (int i = bx * 512 + tid; i < MS * DM / 4; i += G * 512) {
            const int row = MP + i / (DM / 4), c4 = i % (DM / 4); float mu, rs; pg8::row_mu_rstd(ST2, row, mu, rs);
            const f32x4 a = (((p0[i] + p0[i + sl]) + (p0[i + 2 * sl] + p0[i + 3 * sl])) * W8_INV - c1[c4] * mu) * rs + c2[c4];
            const f32x4 h = (Y[i] - mu) * rs * g2[c4] + b2[c4]; const u32x2 ew = Eb[i]; f32x4 y;
            y[0] = h[0] + fast_sigmoid(a[0]) * bf_lo(ew.x); y[1] = h[1] + fast_sigmoid(a[1]) * bf_hi(ew.x); y[2] = h[2] + fast_sigmoid(a[2]) * bf_lo(ew.y); y[3] = h[3] + fast_sigmoid(a[3]) * bf_hi(ew.y);
            Y[i] = y;
        }
    }
}

#undef x_prompt
#undef x_sample
#undef state_pool
#undef state_conv
#undef state_delta
#undef p_prompt
#undef p_sample
#undef w_in
#undef w_pool
#undef pool_scale
#undef w_conv
#undef a_log
#undef dt_bias
#undef o_norm_g
#undef w_out
#undef ln1_g
#undef ln1_b
#undef w_gate_up
#undef w_down
#undef ln2_g
#undef ln2_b
#undef w_ple_gate
#undef w_ple_proj
#undef out
#undef WIN
#undef WOUT
#undef WGU
#undef WDN
#undef WPG
#undef WPP
#undef WPOOL
#undef XB
#undef PB
#undef PROJ
#undef BA
#undef DPOOL
#undef MIXED
#undef GLp
#undef GLASTp
#undef G1O
#undef SLAB
#undef SLAB2
#undef CPART
#undef PST
#undef CF
#undef QN
#undef KN
#undef VC
#undef GAp
#undef GBp
#undef OB
#undef HF
#undef HB
#undef EB
#undef ACT
#undef H2B
#undef H2B8
#undef HB8I
extern "C" void kernel_launch(void* const* d_in, const int* in_sizes, int n_in, void* d_out, int out_size, void* d_ws, size_t ws_size, hipStream_t stream) {
    static int grid = 0;
    if (grid == 0) {
        if (n_in != 23 || (size_t)out_size != OUT_END || ws_size < WS_END) {
            fprintf(stderr, "kernel_launch: unexpected shapes: n_in %d out %d ws %zu (need %zu)\n", n_in, out_size, ws_size, (size_t)WS_END); grid = -1;
        } else {
            int dev = 0, cus = 0;
            if (hipGetDevice(&dev) != hipSuccess || hipDeviceGetAttribute(&cus, hipDeviceAttributeMultiprocessorCount, dev) != hipSuccess) { grid = -1; }
            else if (hipFuncSetAttribute((const void*)hymba_fwd, hipFuncAttributeMaxDynamicSharedMemorySize, LDS_BYTES) != hipSuccess) { fprintf(stderr, "kernel_launch: hipFuncSetAttribute failed\n"); grid = -1; }
            else { int per_cu = 0; (void)hipOccupancyMaxActiveBlocksPerMultiprocessor(&per_cu, (const void*)hymba_fwd, NWAVES * 64, LDS_BYTES); (void)hipGetLastError(); grid = cus; }
        }
    }
    if (grid < 0) { (void)hipMemsetAsync(d_out, 0, (size_t)out_size * 4, stream); return; }
    (void)hipMemsetAsync((char*)d_ws + WS_CTL, 0, CTL_ZERO_BYTES, stream);
    Args a{};
    for (int i = 0; i < 23; ++i) a.in[i] = (const float*)d_in[i];
    a.out = (float*)d_out; a.ws = (unsigned char*)d_ws;
    hipLaunchKernelGGL(hymba_fwd, dim3(grid), dim3(NWAVES * 64), LDS_BYTES, stream, a);
}
```

```cpp
#include <hip/hip_runtime.h>
#include <cstdio>
#include <cstdint>

#define GAS __attribute__((address_space(1)))
#define LAS __attribute__((address_space(3)))
typedef unsigned short bf16_t;
typedef short bf16x8 __attribute__((ext_vector_type(8)));
typedef float f32x4 __attribute__((ext_vector_type(4)));
typedef float f32x2 __attribute__((ext_vector_type(2)));
typedef unsigned u32x4 __attribute__((ext_vector_type(4)));
typedef unsigned u32x2 __attribute__((ext_vector_type(2)));

constexpr int DM = 4096, NB = 4, SEQ = 2048, DB = 128, DS = 8;
constexpr int MP = NB * SEQ, MS = DB * DS, M = MP + MS;
constexpr int PW = 1024, DNW = 3072, HD = 128, NH = 24, CCH = 9216;
constexpr int PROJ_OUT = 13360, PROJ_PAD = 13568, PROJ_LD = 13312;
constexpr int DFF = 11008, PLE = 256;
constexpr float LN_EPS = 1e-5f, RMS_EPS = 1e-6f, L2_EPS = 1e-6f;
constexpr float DN_ALPHA = 1.189207115002721f;
constexpr int O1 = PW, O2 = O1 + CCH, O3 = O2 + DNW;

constexpr size_t OUT_Y = 0;
constexpr size_t OUT_NPP = (size_t)M * DM;
constexpr size_t OUT_NCP = OUT_NPP + (size_t)NB * 15 * PW;
constexpr size_t OUT_NDP = OUT_NCP + (size_t)NB * 3 * CCH;
constexpr size_t OUT_NPS = OUT_NDP + (size_t)NB * NH * HD * HD;
constexpr size_t OUT_NCS = OUT_NPS + (size_t)DB * 15 * PW;
constexpr size_t OUT_NDS = OUT_NCS + (size_t)DB * 3 * CCH;
constexpr size_t OUT_END = OUT_NDS + (size_t)DB * NH * HD * HD;

constexpr size_t MiB = 1u << 20;
constexpr size_t WS_CTL = 0, CTL_ZERO_BYTES = 1 * MiB;
constexpr size_t WS_WIN = 1 * MiB;
constexpr size_t WS_XB = 107 * MiB;
constexpr size_t WS_WOUT = 179 * MiB;
constexpr size_t WS_WGU = 211 * MiB;
constexpr size_t WS_WDN = 383 * MiB;
constexpr size_t WS_WPG = 469 * MiB;
constexpr size_t WS_WPP = 501 * MiB;
constexpr size_t WS_WPOOL = 503 * MiB;
constexpr size_t WS_PB = 504 * MiB;
constexpr size_t WS_PROJ = 509 * MiB;
constexpr size_t WS_BA = 743 * MiB;
constexpr size_t WS_DPOOL = 746 * MiB;
constexpr size_t WS_MIXED = 764 * MiB;
constexpr size_t WS_G1 = 836 * MiB;
constexpr size_t WS_GLAST = 1100 * MiB;
constexpr size_t WS_GA = 1101 * MiB;
constexpr size_t WS_GB = 1102 * MiB;
constexpr size_t WS_GL = 1103 * MiB;
constexpr size_t WS_O = 1104 * MiB;
constexpr size_t WS_CPART = 1212 * MiB;
constexpr size_t WS_PST = 1226 * MiB;
constexpr size_t WS_END = 1232 * MiB;
constexpr int CP_N = 2 * DFF + DM;
constexpr size_t WS_QN = WS_WIN, WS_KN = WS_WIN + 54 * MiB, WS_VC = WS_WIN + 108 * MiB;
constexpr size_t WS_ACT = WS_PROJ, WS_H = WS_G1, WS_HB = WS_G1 + 144 * MiB, WS_E = WS_O, WS_H2B = WS_XB;
constexpr size_t WS_H2B8 = WS_WIN + 65 * MiB;
constexpr float W8_SCALE = 64.f, W8_INV = 1.f / 64.f;
constexpr float A8I_INV = 127.f / 8.f, W8I_INV = 127.f * 64.f / 6.f, GU8I_SCALE = (8.f / 127.f) * (6.f / (127.f * 64.f));
constexpr int WDN8_SCALE = 128; constexpr float ACT8_SCALE = 8.f, DN8_INV = 1.f / (128.f * 8.f);
constexpr size_t WS_SLAB = WS_WIN;
constexpr int G1_CHUNK_BYTES = 71680;
constexpr int G1_WF = 0, G1_QGF = 16384, G1_QKF = 32768, G1_KDF = 38912, G1_UF = 55296;
constexpr int CW_BAR = 4096;
constexpr int CW_ROWS1 = 9216, CW_ROWS2 = 9280;
constexpr size_t CTL_ST1 = 65536, CTL_ST2 = 139264, CTL_C1GU = 262144, CTL_C2GU = 350208, CTL_C1PG = 438272, CTL_C2PG = 454656;

constexpr int RING_BYTES = 160768;
constexpr int LDSCTL_OFF = RING_BYTES, MISC_OFF = LDSCTL_OFF + 320;
constexpr int LDS_BYTES = 161792;
constexpr int NWAVES = 8;

#define LDS_WAIT() asm volatile("s_waitcnt lgkmcnt(0)" ::: "memory")
#define VM_WAIT() asm volatile("s_waitcnt vmcnt(0)" ::: "memory")

__device__ __forceinline__ unsigned f2bf(float f) { unsigned u = __builtin_bit_cast(unsigned, f); return (u + 0x7fffu + ((u >> 16) & 1u)) >> 16; }
__device__ __forceinline__ unsigned pk2(float lo, float hi) { return f2bf(lo) | (f2bf(hi) << 16); }
__device__ __forceinline__ float bf_lo(unsigned w) { return __builtin_bit_cast(float, w << 16); }
__device__ __forceinline__ float bf_hi(unsigned w) { return __builtin_bit_cast(float, w & 0xffff0000u); }
__device__ __forceinline__ int lane_id() { int l; asm volatile("v_mbcnt_lo_u32_b32 %0, -1, 0\n\tv_mbcnt_hi_u32_b32 %0, -1, %0" : "=v"(l)); return l; }
__device__ __forceinline__ float fast_sigmoid(float x) { return __builtin_amdgcn_rcpf(1.f + __builtin_amdgcn_exp2f(-1.4426950408889634f * x)); }

template <int X> __device__ __forceinline__ float swz_xor(float v) { return __builtin_bit_cast(float, __builtin_amdgcn_ds_swizzle(__builtin_bit_cast(int, v), (X << 10) | 0x1f)); }
__device__ __forceinline__ float sum16(float v) { v += swz_xor<1>(v); v += swz_xor<2>(v); v += swz_xor<4>(v); v += swz_xor<8>(v); return v; }
__device__ __forceinline__ float wave_sum(float v) {
    v = sum16(v); v += swz_xor<16>(v);
    return __builtin_bit_cast(float, __builtin_amdgcn_readlane(__builtin_bit_cast(int, v), 0)) + __builtin_bit_cast(float, __builtin_amdgcn_readlane(__builtin_bit_cast(int, v), 32));
}

__device__ __forceinline__ float bperm_f(int src_lane, float v) { return __builtin_bit_cast(float, __builtin_amdgcn_ds_bpermute(src_lane << 2, __builtin_bit_cast(int, v))); }

namespace pg8 {
constexpr int BM = 256, BK = 64, HALF = 128, HTB = HALF * BK * 2, STAGE_BYTES = 8 * HTB, NXCD = 8, WGM = 8;
__host__ __device__ __forceinline__ int lds_byte(int r, int c) { const int st = (r >> 4) * 2 + (c >> 5), rr = r & 15, cc = c & 31, ob = rr * 64 + cc * 2; return st * 1024 + (ob ^ (((ob >> 9) & 1) << 5)); }
__host__ __device__ __forceinline__ void stage_rc(int b, int& R, int& C) { const int st = b / 1024, sb = b % 1024, swz = sb ^ (((sb >> 9) & 1) << 5); R = (st >> 1) * 16 + swz / 64; C = (st & 1) * 32 + (swz % 64) / 2; }
__host__ __device__ __forceinline__ int perm32(int rho) { const int n = rho >> 4, i = rho & 15; return 8 * (i >> 2) + 4 * n + (i & 3); }

struct Unit { int pm, pn, k0, nk, split, aux; };
typedef int v8i_t __attribute__((ext_vector_type(8)));
typedef int v4i_t __attribute__((ext_vector_type(4)));
__device__ __forceinline__ v8i_t cat8(bf16x8 a, bf16x8 b) { const v4i_t x = __builtin_bit_cast(v4i_t, a), y = __builtin_bit_cast(v4i_t, b); return __builtin_shufflevector(x, y, 0, 1, 2, 3, 4, 5, 6, 7); }
__device__ __forceinline__ unsigned pk4_fp8(float a, float b, float c, float d) { int w = 0; w = __builtin_amdgcn_cvt_pk_fp8_f32(a, b, w, false); w = __builtin_amdgcn_cvt_pk_fp8_f32(c, d, w, true); return (unsigned)w; }
__device__ __forceinline__ void st_wt8x(void* p, u32x2 v) { asm volatile("global_store_dwordx2 %0, %1, off sc1\n\ts_nop 1" :: "v"(p), "v"(v) : "memory"); }
typedef int i32x4_t __attribute__((ext_vector_type(4)));
__device__ __forceinline__ unsigned pk4_i8(float a, float b, float c, float d) {
    const int ia = (int)__builtin_rintf(__builtin_fminf(__builtin_fmaxf(a, -127.f), 127.f)), ib = (int)__builtin_rintf(__builtin_fminf(__builtin_fmaxf(b, -127.f), 127.f));
    const int ic = (int)__builtin_rintf(__builtin_fminf(__builtin_fmaxf(c, -127.f), 127.f)), id = (int)__builtin_rintf(__builtin_fminf(__builtin_fmaxf(d, -127.f), 127.f));
    return (unsigned)(ia & 255) | ((unsigned)(ib & 255) << 8) | ((unsigned)(ic & 255) << 16) | ((unsigned)id << 24);
}
struct Gemm { const bf16_t* A; const bf16_t* Bt; int M, N, K, lda, ldb, acol; const unsigned* wait_cnt = nullptr; unsigned wait_n = 0; bool epi_wait = false; };

struct StaticOrder {
    int nM, nN, nwg, G, c, nk_all;
    __device__ void init(int M_, int N_, int K_, int G_, int c_) { nM = M_ / BM; nN = N_ / BM; nwg = nM * nN; G = G_; c = c_; nk_all = K_ / BK; }
    __device__ bool next(int i, Unit& u) const { return map((long)i * G + c, u); }
    __device__ bool map(long L, Unit& u) const {
        if (L >= nwg) return false;
        int wgid = (int)L; { const int q = nwg / NXCD, r = nwg % NXCD, xcd = wgid % NXCD, off = wgid / NXCD; wgid = (xcd < r ? xcd * (q + 1) : r * (q + 1) + (xcd - r) * q) + off; }
        const int nig = WGM * nN, gid = wgid / nig, fm = gid * WGM, gsz = (nM - fm) < WGM ? (nM - fm) : WGM;
        u.pm = fm + ((wgid % nig) % gsz); u.pn = (wgid % nig) / gsz; u.k0 = 0; u.nk = nk_all; u.split = -1; u.aux = 0; return true;
    }
};
constexpr int GU_LEFT = 24, GU_LEFT_PN0 = 86 - GU_LEFT;
struct GUOrder {
    StaticOrder sp; int G, c;
    __device__ void init(int G_, int c_, int K_ = DM) { sp.init(8192, 2 * DFF, K_, G_, c_); G = G_; c = c_; }
    __device__ bool next(int i, Unit& u) const {
        if (G != 256) return false;
        if (i < 12) { const int L = i * 256 + c; if (L < 32 * 86) return sp.map(L, u);
            const int sidx = L - 32 * 86; u.pm = 32 + sidx / 86; u.pn = sidx % 86; u.k0 = 0; u.nk = sp.nk_all; u.split = -1; u.aux = 0; return true; }
        if (i > 12 || c >= GU_LEFT * 8) return false;
        const int ul = c % GU_LEFT, sl = c / GU_LEFT; u.pm = 35; u.pn = GU_LEFT_PN0 + ul; u.k0 = (sp.nk_all / 8) * sl; u.nk = sp.nk_all / 8; u.split = sl; u.aux = ul; return true;
    }
};
struct SplitOrder {
    StaticOrder so; int q, r2;
    __device__ void init(int N_, int K_, int G_, int c_) { so.init(8192, N_, K_, G_, c_); const int nt = K_ / BK; q = (nt / 4) & ~1; r2 = (nt - 4 * q) / 2; }
    __device__ bool next(int i, Unit& u) const {
        if (i < 2) return so.next(i, u);
        if (i > 2 || so.G != 256) return false;
        const int c = so.c, sl = c & 3, tl = (c >> 3) + 32 * ((c >> 2) & 1);
        u.pm = 32 + (tl >> 4); u.pn = tl & 15; u.k0 = sl * q + 2 * (sl < r2 ? sl : r2); u.nk = q + (sl < r2 ? 2 : 0); u.split = sl; u.aux = 0; return true;
    }
};

__device__ __forceinline__ unsigned cvt_pk_bf16(float lo, float hi) { unsigned r; asm volatile("v_cvt_pk_bf16_f32 %0, %1, %2" : "=v"(r) : "v"(lo), "v"(hi)); return r; }

template <class Epi, class Order = StaticOrder, bool ALIGN_EPI = true, int QM = 0>
__device__ __forceinline__ void gemm_phase(LAS unsigned char* lds, const Gemm g, const Order& S, const Epi& E, const int wid) {
    int lane_ = lane_id(); asm volatile("" : "+v"(lane_));
    const int lane = lane_, tid = wid * 64 + lane, wr = wid >> 2, wc = wid & 3, fr = lane & 15, fq = lane >> 4;
    unsigned voffA[2], voffB[2];
#pragma unroll
    for (int i = 0; i < 2; ++i) { int R, C; stage_rc(tid * 16 + i * 8192, R, C); const int Rb = Epi::PERM ? ((R & ~31) + perm32(R & 31)) : R;
        voffA[i] = (unsigned)(R * g.lda + C) * 2u; voffB[i] = (unsigned)(Rb * g.ldb + C) * 2u; }
    const size_t kstep = (size_t)(BK * 2);
    const size_t hstepA = (size_t)HALF * g.lda * 2, hstepB = (size_t)HALF * g.ldb * 2;
    const size_t tstepA = 2 * hstepA, tstepB = 2 * hstepB, cstepA = (size_t)g.acol * 2;
    const unsigned ldsw = (unsigned)wid * 1024u;
    const int aoff = lds_byte(wr * 64 + fr, fq * 8), boff = lds_byte(wc * 32 + fr, fq * 8);
#define PG8_SA(b, h) (((b) * 2 + (h)) * HTB)
#define PG8_SB(b, h) ((4 + (b) * 2 + (h)) * HTB)
#define PG8_STAGE(bufoff, gbase, voff) do { _Pragma("unroll") for (int _i = 0; _i < 2; ++_i) \
        __builtin_amdgcn_global_load_lds((const unsigned*)((const char*)(gbase) + (voff)[_i]), (LAS unsigned*)(lds + (bufoff) + ldsw + _i * 8192), 16, 0, 0); } while (0)
#define PG8_LDA(dst, b, h) do { _Pragma("unroll") for (int m = 0; m < 4; ++m) _Pragma("unroll") for (int k = 0; k < 2; ++k) dst[m][k] = *(const LAS bf16x8*)(lds + PG8_SA(b, h) + aoff + m * 2048 + k * 1024); } while (0)
#define PG8_LDB(dst, b, h) do { _Pragma("unroll") for (int n = 0; n < 2; ++n) _Pragma("unroll") for (int k = 0; k < 2; ++k) dst[n][k] = *(const LAS bf16x8*)(lds + PG8_SB(b, h) + boff + n * 2048 + k * 1024); } while (0)
#define PG8_MMA(ai, bj, At, Bt) do { __builtin_amdgcn_s_setprio(1); if constexpr (QM == 2) { _Pragma("unroll") for (int m = 0; m < 4; ++m) _Pragma("unroll") for (int n = 0; n < 2; ++n) _Pragma("unroll") for (int k = 0; k < 2; ++k) \
        acc[ai][bj][m][n] = __builtin_bit_cast(f32x4, __builtin_amdgcn_mfma_i32_16x16x64_i8(__builtin_bit_cast(i32x4_t, Bt[n][k]), __builtin_bit_cast(i32x4_t, At[m][k]), __builtin_bit_cast(i32x4_t, acc[ai][bj][m][n]), 0, 0, 0)); } else if constexpr (QM == 1) { _Pragma("unroll") for (int m = 0; m < 4; ++m) _Pragma("unroll") for (int n = 0; n < 2; ++n) \
        asm volatile("v_mfma_f32_16x16x128_f8f6f4 %0, %1, %2, %0" : "+v"(acc[ai][bj][m][n]) : "v"(cat8(Bt[n][0], Bt[n][1])), "v"(cat8(At[m][0], At[m][1]))); } else { \
        _Pragma("unroll") for (int m = 0; m < 4; ++m) _Pragma("unroll") for (int n = 0; n < 2; ++n) _Pragma("unroll") for (int k = 0; k < 2; ++k) \
        acc[ai][bj][m][n] = __builtin_amdgcn_mfma_f32_16x16x32_bf16(Bt[n][k], At[m][k], acc[ai][bj][m][n], 0, 0, 0); } __builtin_amdgcn_s_setprio(0); } while (0)
#define PG8_WAIT_V(n) asm volatile("s_waitcnt vmcnt(" #n ")" ::: "memory")
#define PG8_WAIT_L(n) asm volatile("s_waitcnt lgkmcnt(" #n ")" ::: "memory")
#define PG8_BAR __builtin_amdgcn_s_barrier()
#define PG8_SCHED __builtin_amdgcn_sched_barrier(0)
    Unit cur, nxt; int ui = 0; bool waited = false, ewaited = false;
    if (!S.next(0, cur)) return;
    f32x4 acc[2][2][4][2];
#pragma unroll
    for (int a = 0; a < 2; ++a)
#pragma unroll
        for (int b = 0; b < 2; ++b)
#pragma unroll
            for (int m = 0; m < 4; ++m)
#pragma unroll
                for (int n = 0; n < 2; ++n) acc[a][b][m][n] = (f32x4){0.f, 0.f, 0.f, 0.f};
    bf16x8 At[4][2], B0[2][2], B1[2][2];
    const char* cA = (const char*)g.A + (size_t)cur.pm * tstepA + (size_t)cur.pn * cstepA + (size_t)cur.k0 * kstep; const char* cB = (const char*)g.Bt + (size_t)cur.pn * tstepB + (size_t)cur.k0 * kstep;
    PG8_STAGE(PG8_SB(0, 0), cB, voffB); PG8_STAGE(PG8_SB(0, 1), cB + hstepB, voffB); PG8_STAGE(PG8_SA(0, 0), cA, voffA); PG8_STAGE(PG8_SA(0, 1), cA + hstepA, voffA);
    if (wr == 1) PG8_BAR;
    PG8_WAIT_V(2); PG8_BAR;
    PG8_STAGE(PG8_SB(1, 0), cB + kstep, voffB); PG8_STAGE(PG8_SA(1, 0), cA + kstep, voffA); PG8_STAGE(PG8_SB(1, 1), cB + hstepB + kstep, voffB);
    PG8_WAIT_V(6); PG8_BAR;
    for (;;) {
        const bool has_next = S.next(ui + 1, nxt);
        const char* nA = has_next ? (const char*)g.A + (size_t)nxt.pm * tstepA + (size_t)nxt.pn * cstepA + (size_t)nxt.k0 * kstep : cA; const char* nB = has_next ? (const char*)g.Bt + (size_t)nxt.pn * tstepB + (size_t)nxt.k0 * kstep : cB;
        const int nt = cur.nk;
        if (g.wait_cnt && has_next && nxt.pm >= 32 && !waited) { waited = true;
            unsigned sp_ = 0; while (__hip_atomic_load(g.wait_cnt, __ATOMIC_RELAXED, __HIP_MEMORY_SCOPE_AGENT) < g.wait_n && ++sp_ < (1u << 22)) __builtin_amdgcn_s_sleep(4);
            __builtin_amdgcn_fence(__ATOMIC_ACQUIRE, "agent"); asm volatile("s_waitcnt vmcnt(0)" ::: "memory"); }
        for (int t = 0; t < nt; t += 2) {
            const bool last = (t == nt - 2);
            const char* a1 = cA + (size_t)(t + 1) * kstep;
            const char* a2 = last ? nA : cA + (size_t)(t + 2) * kstep; const char* b2 = last ? nB : cB + (size_t)(t + 2) * kstep;
            const char* a3 = a2 + kstep; const char* b3 = b2 + kstep;
            PG8_LDB(B0, 0, 0); PG8_LDB(B1, 0, 1); PG8_SCHED; PG8_LDA(At, 0, 0); PG8_STAGE(PG8_SA(1, 1), a1 + hstepA, voffA);
            PG8_WAIT_V(8); PG8_WAIT_L(0); PG8_BAR; PG8_MMA(0, 0, At, B0); PG8_MMA(0, 1, At, B1); PG8_BAR; PG8_SCHED;
            PG8_LDA(At, 0, 1); PG8_STAGE(PG8_SB(0, 0), b2, voffB); PG8_STAGE(PG8_SB(0, 1), b2 + hstepB, voffB); PG8_STAGE(PG8_SA(0, 0), a2, voffA);
            PG8_WAIT_V(8); PG8_WAIT_L(0); PG8_BAR; PG8_MMA(1, 0, At, B0); PG8_MMA(1, 1, At, B1); PG8_BAR; PG8_SCHED;
            PG8_LDB(B0, 1, 0); PG8_LDB(B1, 1, 1); PG8_SCHED; PG8_LDA(At, 1, 0); PG8_STAGE(PG8_SA(0, 1), a2 + hstepA, voffA);
            PG8_WAIT_V(8); PG8_WAIT_L(0); PG8_BAR; PG8_MMA(0, 0, At, B0); PG8_MMA(0, 1, At, B1); PG8_BAR; PG8_SCHED;
            PG8_LDA(At, 1, 1); PG8_STAGE(PG8_SB(1, 0), b3, voffB); PG8_STAGE(PG8_SB(1, 1), b3 + hstepB, voffB); PG8_STAGE(PG8_SA(1, 0), a3, voffA);
            PG8_WAIT_V(8); PG8_WAIT_L(0); PG8_BAR; PG8_MMA(1, 0, At, B0); PG8_MMA(1, 1, At, B1); PG8_BAR; PG8_SCHED;
        }
        if constexpr (QM == 1) { asm volatile("s_nop 15\n\ts_nop 15" ::: "memory"); }
        if (g.epi_wait && !ewaited) { ewaited = true;
            unsigned sp_ = 0; while (__hip_atomic_load(g.wait_cnt, __ATOMIC_RELAXED, __HIP_MEMORY_SCOPE_AGENT) < g.wait_n && ++sp_ < (1u << 22)) __builtin_amdgcn_s_sleep(4);
            __builtin_amdgcn_fence(__ATOMIC_ACQUIRE, "agent"); asm volatile("s_waitcnt vmcnt(0)" ::: "memory"); }
        if constexpr (ALIGN_EPI) { if (wr == 0) PG8_BAR; }
        E(acc, cur, wr, wc, fr, fq);
        if (!has_next) break;
#pragma unroll
        for (int a = 0; a < 2; ++a)
#pragma unroll
            for (int b = 0; b < 2; ++b)
#pragma unroll
                for (int m = 0; m < 4; ++m)
#pragma unroll
                    for (int n = 0; n < 2; ++n) acc[a][b][m][n] = (f32x4){0.f, 0.f, 0.f, 0.f};
        cur = nxt; cA = nA; cB = nB; ++ui;
        if constexpr (ALIGN_EPI) { if (wr == 1) PG8_BAR; }
    }
    PG8_WAIT_V(0);
    if constexpr (!ALIGN_EPI) { if (wr == 0) PG8_BAR; }
    PG8_BAR;
#undef PG8_SA
#undef PG8_SB
#undef PG8_STAGE
#undef PG8_LDA
#undef PG8_LDB
#undef PG8_MMA
#undef PG8_WAIT_V
#undef PG8_WAIT_L
#undef PG8_BAR
#undef PG8_SCHED
}

typedef const f32x4 (&AccRef)[2][2][4][2];
struct f32x4_acc_t { f32x4 v[2][2][4][2]; };

struct EpiProj {
    static constexpr bool PERM = true;
    bf16_t* P; float* BA; float* out;
    __device__ __forceinline__ void operator()(AccRef acc, const Unit& u, int wr, int wc, int fr, int fq) const {
        const int row0 = u.pm * BM + wr * 64 + fr, colw = wc * 32 + 8 * fq;
        const bool sample = u.pm >= 32; const bool tailp = (u.pm & 7) == 7;
#pragma unroll
        for (int ai = 0; ai < 2; ++ai)
#pragma unroll
            for (int m = 0; m < 4; ++m) {
                const int row = row0 + ai * HALF + m * 16;
#pragma unroll
                for (int bj = 0; bj < 2; ++bj) {
                    const f32x4 v0 = acc[ai][bj][m][0], v1 = acc[ai][bj][m][1];
                    const int colt = bj * HALF + colw;
                    const int col = u.pn * BM + colt;
                    if (u.pn < 52) {
                        u32x4 w; w.x = cvt_pk_bf16(v0[0], v0[1]); w.y = cvt_pk_bf16(v0[2], v0[3]); w.z = cvt_pk_bf16(v1[0], v1[1]); w.w = cvt_pk_bf16(v1[2], v1[3]);
                        *(u32x4*)(P + (size_t)row * PROJ_LD + col) = w;
                    } else if (colt < 64) {
                        float* d = BA + (size_t)row * 64 + colt; *(f32x4*)d = v0; *(f32x4*)(d + 4) = v1;
                    }
                    if (u.pn < 40) {
                        float* dst = nullptr;
                        if (!sample) {
                            if (tailp) { const int b = row >> 11, t = row & 2047;
                                if (u.pn < 4) { if (t >= SEQ - 15) dst = out + OUT_NPP + ((size_t)(b * 15 + t - (SEQ - 15))) * PW + col; }
                                else          { if (t >= SEQ - 3)  dst = out + OUT_NCP + ((size_t)(b * 3 + t - (SEQ - 3))) * CCH + (col - O1); } }
                        } else { const int s = row - MP, b = s >> 3, t = s & 7;
                            if (u.pn < 4) dst = out + OUT_NPS + ((size_t)(b * 15 + 7 + t)) * PW + col;
                            else if (t >= 5) dst = out + OUT_NCS + ((size_t)(b * 3 + t - 5)) * CCH + (col - O1); }
                        if (dst) { *(f32x4*)dst = v0; *(f32x4*)(dst + 4) = v1; }
                    }
                }
            }
    }
};
struct EpiBf16S {
    static constexpr bool PERM = true;
    bf16_t* O; int ldc; const float* scale;
    __device__ __forceinline__ void operator()(AccRef acc, const Unit& u, int wr, int wc, int fr, int fq) const {
        const int row0 = u.pm * BM + wr * 64 + fr, col0 = u.pn * BM + wc * 32 + 8 * fq;
#pragma unroll
        for (int bj = 0; bj < 2; ++bj) {
            f32x4 s0 = (f32x4){1.f, 1.f, 1.f, 1.f}, s1 = s0;
            if (scale) { s0 = *(const f32x4*)(scale + col0 + bj * HALF); s1 = *(const f32x4*)(scale + col0 + bj * HALF + 4); }
#pragma unroll
            for (int ai = 0; ai < 2; ++ai)
#pragma unroll
                for (int m = 0; m < 4; ++m) {
                    const f32x4 v0 = acc[ai][bj][m][0] * s0, v1 = acc[ai][bj][m][1] * s1;
                    u32x4 w; w.x = cvt_pk_bf16(v0[0], v0[1]); w.y = cvt_pk_bf16(v0[2], v0[3]); w.z = cvt_pk_bf16(v1[0], v1[1]); w.w = cvt_pk_bf16(v1[2], v1[3]);
                    *(u32x4*)(O + (size_t)(row0 + ai * HALF + m * 16) * ldc + col0 + bj * HALF) = w;
                }
        }
    }
};
__device__ __forceinline__ void store_partial(AccRef acc, const Unit& u, float* slab, int wr, int wc, int fr, int fq) {
    const int row0 = (u.pm - 32) * BM + wr * 64 + fr, col0 = u.pn * BM + wc * 32 + 4 * fq; bf16_t* S = (bf16_t*)slab + (size_t)u.split * MS * DM;
#pragma unroll
    for (int ai = 0; ai < 2; ++ai)
#pragma unroll
        for (int m = 0; m < 4; ++m) { const size_t off = (size_t)(row0 + ai * HALF + m * 16) * DM + col0;
#pragma unroll
            for (int bj = 0; bj < 2; ++bj)
#pragma unroll
                for (int n = 0; n < 2; ++n) { const f32x4 a = acc[ai][bj][m][n]; u32x2 w; w.x = cvt_pk_bf16(a[0], a[1]); w.y = cvt_pk_bf16(a[2], a[3]); *(u32x2*)(S + off + bj * HALF + n * 16) = w; } }
}
struct EpiResid {
    static constexpr bool PERM = false;
    const float* R0; const float* R1; int split; float* O; float* slab;
    __device__ __forceinline__ void operator()(AccRef acc, const Unit& u, int wr, int wc, int fr, int fq) const {
        if (u.split >= 0) { store_partial(acc, u, slab, wr, wc, fr, fq); return; }
        const int row0 = u.pm * BM + wr * 64 + fr, col0 = u.pn * BM + wc * 32 + 4 * fq;
        const float* R = (u.pm * BM < split) ? R0 : R1 - (size_t)split * DM;
#pragma unroll
        for (int ai = 0; ai < 2; ++ai)
#pragma unroll
            for (int m = 0; m < 4; ++m) { const size_t off = (size_t)(row0 + ai * HALF + m * 16) * DM + col0;
#pragma unroll
                for (int bj = 0; bj < 2; ++bj)
#pragma unroll
                    for (int n = 0; n < 2; ++n) { const f32x4 r = *(const f32x4*)(R + off + bj * HALF + n * 16); *(f32x4*)(O + off + bj * HALF + n * 16) = r * DN_ALPHA + acc[ai][bj][m][n]; } }
    }
};
struct EpiSwiGLU {
    static constexpr bool PERM = true;
    bf16_t* O;
    __device__ __forceinline__ void operator()(AccRef acc, const Unit& u, int wr, int wc, int fr, int fq) const {
        const int row0 = u.pm * BM + wr * 64 + fr, col0 = u.pn * HALF + wc * 32 + 8 * fq;
#pragma unroll
        for (int ai = 0; ai < 2; ++ai)
#pragma unroll
            for (int m = 0; m < 4; ++m) {
                f32x4 a0 = acc[ai][0][m][0], a1 = acc[ai][0][m][1]; const f32x4 b0 = acc[ai][1][m][0], b1 = acc[ai][1][m][1];
#pragma unroll
                for (int j = 0; j < 4; ++j) { a0[j] = a0[j] * fast_sigmoid(a0[j]) * b0[j]; a1[j] = a1[j] * fast_sigmoid(a1[j]) * b1[j]; }
                u32x4 w; w.x = cvt_pk_bf16(a0[0], a0[1]); w.y = cvt_pk_bf16(a0[2], a0[3]); w.z = cvt_pk_bf16(a1[0], a1[1]); w.w = cvt_pk_bf16(a1[2], a1[3]);
                *(u32x4*)(O + (size_t)(row0 + ai * HALF + m * 16) * DFF + col0) = w;
            }
    }
};
struct EpiFinal {
    static constexpr bool PERM = false;
    float* Y; const bf16_t* E; float* slab;
    __device__ __forceinline__ void operator()(AccRef acc, const Unit& u, int wr, int wc, int fr, int fq) const {
        if (u.split >= 0) { store_partial(acc, u, slab, wr, wc, fr, fq); return; }
        const int row0 = u.pm * BM + wr * 64 + fr, col0 = u.pn * BM + wc * 32 + 4 * fq;
#pragma unroll
        for (int ai = 0; ai < 2; ++ai)
#pragma unroll
            for (int m = 0; m < 4; ++m) { const size_t off = (size_t)(row0 + ai * HALF + m * 16) * DM + col0;
#pragma unroll
                for (int bj = 0; bj < 2; ++bj)
#pragma unroll
                    for (int n = 0; n < 2; ++n) { const size_t o = off + bj * HALF + n * 16; const f32x4 h = *(const f32x4*)(Y + o); const u32x2 ew = *(const u32x2*)(E + o);
                        const f32x4 a = acc[ai][bj][m][n]; f32x4 y;
                        y[0] = h[0] + fast_sigmoid(a[0]) * bf_lo(ew.x); y[1] = h[1] + fast_sigmoid(a[1]) * bf_hi(ew.x);
                        y[2] = h[2] + fast_sigmoid(a[2]) * bf_lo(ew.y); y[3] = h[3] + fast_sigmoid(a[3]) * bf_hi(ew.y);
                        *(f32x4*)(Y + o) = y; } }
    }
};

__device__ __forceinline__ void row_mu_rstd(const float* ST, int row, float& mu, float& rstd) { const f32x2 v = *(const f32x2*)(ST + 2 * (size_t)row); mu = v.x; rstd = v.y; }
__device__ __forceinline__ f32x2 stats_finalize(float sm, float sq) { const float mu = sm * (1.0f / DM); return (f32x2){mu, 1.0f / sqrtf(fmaxf(sq * (1.0f / DM) - mu * mu, 0.f) + LN_EPS)}; }
template <int MODE> struct EpiLNRes {
    static constexpr bool PERM = false;
    const float* R0; const bf16_t* RB; bf16_t* TB; float* ST; float* slab; const float* STin; const float* gin; const float* bin; unsigned char* T8 = nullptr; float asc = 1.f;
    __device__ __forceinline__ void operator()(AccRef acc, const Unit& u, int wr, int wc, int fr, int fq) const {
        if (u.split >= 0) { store_partial(acc, u, slab, wr, wc, fr, fq); return; }
        const int row0 = u.pm * BM + wr * 64 + fr, col0 = u.pn * BM + wc * 32 + 4 * fq, lane = fr + 16 * fq;
        f32x4 gg[2][2], bb[2][2];
        if (MODE == 1) {
#pragma unroll
            for (int bj = 0; bj < 2; ++bj)
#pragma unroll
                for (int n = 0; n < 2; ++n) { gg[bj][n] = *(const f32x4*)(gin + col0 + bj * HALF + n * 16); bb[bj][n] = *(const f32x4*)(bin + col0 + bj * HALF + n * 16); }
        }
#pragma unroll
        for (int ai = 0; ai < 2; ++ai)
#pragma unroll
            for (int m = 0; m < 4; ++m) { const int row = row0 + ai * HALF + m * 16; const size_t off = (size_t)row * DM + col0;
                float mu = 0.f, rs = 1.f; if (MODE == 1) row_mu_rstd(STin, row, mu, rs);
                float sm = 0.f, sq = 0.f;
#pragma unroll
                for (int bj = 0; bj < 2; ++bj)
#pragma unroll
                    for (int n = 0; n < 2; ++n) { f32x4 r;
                        { const u32x2 rw = *(const u32x2*)(RB + off + bj * HALF + n * 16); r = (f32x4){bf_lo(rw.x), bf_hi(rw.x), bf_lo(rw.y), bf_hi(rw.y)}; }
                        if (MODE == 1) r = (r - mu) * rs * gg[bj][n] + bb[bj][n];
                        const f32x4 t = r * DN_ALPHA + acc[ai][bj][m][n] * asc;
                        u32x2 w; w.x = cvt_pk_bf16(t[0], t[1]); w.y = cvt_pk_bf16(t[2], t[3]); *(u32x2*)(TB + off + bj * HALF + n * 16) = w;
                        if (MODE == 1) *(unsigned*)(T8 + off + bj * HALF + n * 16) = pk4_fp8(t[0], t[1], t[2], t[3]);
                        else if (T8) *(unsigned*)(T8 + off + bj * HALF + n * 16) = pk4_i8(t[0] * A8I_INV, t[1] * A8I_INV, t[2] * A8I_INV, t[3] * A8I_INV);
                        sm += (t[0] + t[1]) + (t[2] + t[3]); sq += (t[0] * t[0] + t[1] * t[1]) + (t[2] * t[2] + t[3] * t[3]); }
                sm += swz_xor<16>(sm); sq += swz_xor<16>(sq);
                sm += bperm_f(lane ^ 32, sm); sq += bperm_f(lane ^ 32, sq);
                if (fq == 0) *(f32x2*)(ST + ((size_t)row * 64 + u.pn * 4 + wc) * 2) = (f32x2){sm, sq}; }
    }
};
struct EpiSwiGLULN {
    static constexpr bool PERM = true;
    bf16_t* O; const float* ST; const float* C1; const float* C2; float* slab2; float asc = 0.f; int only = -1; bool wt = false;
    __device__ __forceinline__ f32x4 accf(const f32x4& a) const { return asc != 0.f ? __builtin_convertvector(__builtin_bit_cast(i32x4_t, a), f32x4) * asc : a; }
    __device__ __forceinline__ void operator()(AccRef acc, const Unit& u, int wr, int wc, int fr, int fq) const {
        if (u.split >= 0) { f32x4* d = (f32x4*)slab2 + ((size_t)((u.aux * 8 + u.split) * 8 + wr * 4 + wc) * 32) * 64 + fr + 16 * fq;
#pragma unroll
            for (int ai = 0; ai < 2; ++ai)
#pragma unroll
                for (int bj = 0; bj < 2; ++bj)
#pragma unroll
                    for (int m = 0; m < 4; ++m)
#pragma unroll
                        for (int n = 0; n < 2; ++n) d[(((ai * 2 + bj) * 4 + m) * 2 + n) * 64] = accf(acc[ai][bj][m][n]);
            return; }
        const int row0 = u.pm * BM + wr * 64 + fr, col0 = u.pn * HALF + wc * 32 + 8 * fq, cw = u.pn * BM + wc * 32 + 8 * fq;
        f32x4 c1[2][2], c2[2][2];
#pragma unroll
        for (int bj = 0; bj < 2; ++bj)
#pragma unroll
            for (int n = 0; n < 2; ++n) { c1[bj][n] = *(const f32x4*)(C1 + cw + bj * HALF + 4 * n); c2[bj][n] = *(const f32x4*)(C2 + cw + bj * HALF + 4 * n); }
#pragma unroll
        for (int ai = 0; ai < 2; ++ai)
#pragma unroll
            for (int m = 0; m < 4; ++m) { if (only >= 0 && only != ai * 4 + m) continue;
                const int row = row0 + ai * HALF + m * 16; float mu, rs; row_mu_rstd(ST, row, mu, rs);
                f32x4 a0 = (accf(acc[ai][0][m][0]) - c1[0][0] * mu) * rs + c2[0][0], a1 = (accf(acc[ai][0][m][1]) - c1[0][1] * mu) * rs + c2[0][1];
                const f32x4 b0 = (accf(acc[ai][1][m][0]) - c1[1][0] * mu) * rs + c2[1][0], b1 = (accf(acc[ai][1][m][1]) - c1[1][1] * mu) * rs + c2[1][1];
#pragma unroll
                for (int j = 0; j < 4; ++j) { a0[j] = a0[j] * fast_sigmoid(a0[j]) * b0[j]; a1[j] = a1[j] * fast_sigmoid(a1[j]) * b1[j]; }
                u32x2 w; w.x = pk4_fp8(a0[0] * ACT8_SCALE, a0[1] * ACT8_SCALE, a0[2] * ACT8_SCALE, a0[3] * ACT8_SCALE); w.y = pk4_fp8(a1[0] * ACT8_SCALE, a1[1] * ACT8_SCALE, a1[2] * ACT8_SCALE, a1[3] * ACT8_SCALE);
                if (wt) st_wt8x((unsigned char*)O + (size_t)row * DFF + col0, w); else *(u32x2*)((unsigned char*)O + (size_t)row * DFF + col0) = w; }
    }
};
struct EpiFinalLN {
    static constexpr bool PERM = false;
    float* Y; const bf16_t* TB; const bf16_t* E; float* slab; const float* ST; const float* C1; const float* C2; const float* gin; const float* bin;
    __device__ __forceinline__ void operator()(AccRef acc, const Unit& u, int wr, int wc, int fr, int fq) const {
        if (u.split >= 0) { store_partial(acc, u, slab, wr, wc, fr, fq); return; }
        const int row0 = u.pm * BM + wr * 64 + fr, col0 = u.pn * BM + wc * 32 + 4 * fq;
        f32x4 gg[2][2], bb[2][2], c1[2][2], c2[2][2];
#pragma unroll
        for (int bj = 0; bj < 2; ++bj)
#pragma unroll
            for (int n = 0; n < 2; ++n) { const int c = col0 + bj * HALF + n * 16; gg[bj][n] = *(const f32x4*)(gin + c); bb[bj][n] = *(const f32x4*)(bin + c); c1[bj][n] = *(const f32x4*)(C1 + c); c2[bj][n] = *(const f32x4*)(C2 + c); }
#pragma unroll
        for (int ai = 0; ai < 2; ++ai)
#pragma unroll
            for (int m = 0; m < 4; ++m) { const int row = row0 + ai * HALF + m * 16; const size_t off = (size_t)row * DM + col0; float mu, rs; row_mu_rstd(ST, row, mu, rs);
#pragma unroll
                for (int bj = 0; bj < 2; ++bj)
#pragma unroll
                    for (int n = 0; n < 2; ++n) { const size_t o = off + bj * HALF + n * 16; const u32x2 tw = *(const u32x2*)(TB + o); const f32x4 t = (f32x4){bf_lo(tw.x), bf_hi(tw.x), bf_lo(tw.y), bf_hi(tw.y)}; const u32x2 ew = *(const u32x2*)(E + o);
                        const f32x4 h = (t - mu) * rs * gg[bj][n] + bb[bj][n]; const f32x4 a = (acc[ai][bj][m][n] * W8_INV - c1[bj][n] * mu) * rs + c2[bj][n]; f32x4 y;
                        y[0] = h[0] + fast_sigmoid(a[0]) * bf_lo(ew.x); y[1] = h[1] + fast_sigmoid(a[1]) * bf_hi(ew.x);
                        y[2] = h[2] + fast_sigmoid(a[2]) * bf_lo(ew.y); y[3] = h[3] + fast_sigmoid(a[3]) * bf_hi(ew.y);
                        *(f32x4*)(Y + o) = y; } }
    }
};
}

#define XB_TMO      128
#define XB_XCNT(j)  (256  + 64 * (j))
#define XB_XSUB(j)  (1280 + 64 * (j))
#define XB_XGEN(j)  (2304 + 64 * (j))
#define XB_TOP      3328
#define XB_TOPGEN   3392
#define XCD_BAR_WORDS 3456
#define XB_SPIN_CAP (1u << 18)
__device__ __forceinline__ unsigned xb_ld(unsigned* p)              { return __hip_atomic_load(p, __ATOMIC_RELAXED, __HIP_MEMORY_SCOPE_AGENT); }
__device__ __forceinline__ unsigned xb_add(unsigned* p, unsigned v) { return __hip_atomic_fetch_add(p, v, __ATOMIC_RELAXED, __HIP_MEMORY_SCOPE_AGENT); }
__device__ __forceinline__ unsigned xb_xcc_id() { return (unsigned)__builtin_amdgcn_s_getreg((3 << 11) | 20) & 0xFu; }
#define XB_SPIN(cond, bar) do { unsigned _sp = 0; while (cond) { __builtin_amdgcn_s_sleep(1); \
    if ((++_sp & 255u) == 0u) { if (xb_ld(&(bar)[XB_TMO])) break; if (_sp > XB_SPIN_CAP) { atomicAdd(&(bar)[XB_TMO], 1u); break; } } } } while (0)
struct XcdBarrier { unsigned* bar; unsigned x; volatile LAS unsigned* st; };
__device__ __forceinline__ XcdBarrier xcd_barrier_post(unsigned* bar, volatile LAS unsigned* st) {
    XcdBarrier b; b.bar = bar; b.x = xb_xcc_id(); b.st = st;
    if (threadIdx.x == 0) (void)xb_add(&bar[XB_XCNT(b.x)], 1u);
    return b;
}
__device__ __forceinline__ void xcd_barrier_complete(unsigned* bar, unsigned x, unsigned& nloc, unsigned& nx) {
    const unsigned G = gridDim.x * gridDim.y * gridDim.z;
    unsigned sum, cnt, mine, sp = 0u;
    for (;;) {
        sum = 0u; cnt = 0u; mine = 0u;
#pragma unroll
        for (unsigned j = 0; j < 16; ++j) { const unsigned c = xb_ld(&bar[XB_XCNT(j)]); sum += c; cnt += (c > 0u) ? 1u : 0u; mine = (j == x) ? c : mine; }
        if (sum == G) break;
        __builtin_amdgcn_s_sleep(1);
        if ((++sp & 255u) == 0u) { if (xb_ld(&bar[XB_TMO])) break; if (sp > XB_SPIN_CAP) { atomicAdd(&bar[XB_TMO], 1u); break; } }
    }
    nloc = mine > 0u ? mine : 1u; nx = cnt > 0u ? cnt : 1u;
}
__device__ __forceinline__ void xcd_barrier(const XcdBarrier& b) {
    asm volatile("s_waitcnt vmcnt(0)" ::: "memory");
    __syncthreads();
    if (threadIdx.x == 0) {
        unsigned* bar = b.bar;
        __builtin_amdgcn_s_waitcnt(0);
        unsigned nloc = b.st[0], nx = b.st[1];
        if (nloc == 0u) { xcd_barrier_complete(bar, b.x, nloc, nx); b.st[0] = nloc; b.st[1] = nx; }
        const unsigned old = xb_add(&bar[XB_XSUB(b.x)], 1u);
        const unsigned gen = old / nloc;
        if (old + 1u == (gen + 1u) * nloc) {
            __builtin_amdgcn_fence(__ATOMIC_RELEASE, "agent");
            asm volatile("s_waitcnt vmcnt(0)" ::: "memory");
            const unsigned og = xb_add(&bar[XB_TOP], 1u);
            const unsigned tg = og / nx;
            if (og + 1u == (tg + 1u) * nx) xb_add(&bar[XB_TOPGEN], 1u);
            else XB_SPIN(xb_ld(&bar[XB_TOPGEN]) == tg, bar);
            __builtin_amdgcn_fence(__ATOMIC_ACQUIRE, "agent");
            xb_add(&bar[XB_XGEN(b.x)], 1u);
            asm volatile("s_waitcnt vmcnt(0)" ::: "memory");
        } else {
            XB_SPIN(xb_ld(&bar[XB_XGEN(b.x)]) == gen, bar);
            __builtin_amdgcn_fence(__ATOMIC_ACQUIRE, "agent");
            asm volatile("s_waitcnt vmcnt(0)" ::: "memory");
        }
    }
    __syncthreads();
}

struct Args { const float* in[23]; float* out; unsigned char* ws; int pad0, pad1; };

template <int MODE, int LNF = 0, int F8 = 0, int I8 = 0>
__device__ __forceinline__ void transpose_item(const float* __restrict__ W, int K, int N, bf16_t* WT, LAS float* scr, int item, int lane,
                                               const float* __restrict__ lng = nullptr, const float* __restrict__ lnb = nullptr, float* c1 = nullptr, float* c2 = nullptr) {
    const int nblk = (N + 31) / 32, kb = item / nblk, nb = item % nblk, k0 = 64 * kb, n0 = 32 * nb;
    const int nn = n0 + (lane & 31); const bool ok = nn < N; const int hi = lane >> 5;
    float wv[32];
    const float* wp = W + (size_t)(k0 + hi) * N + (ok ? nn : 0);
#pragma unroll
    for (int i = 0; i < 32; ++i) wv[i] = wp[(size_t)(2 * i) * N];
    if (LNF) {
        float s1 = 0.f, s2 = 0.f;
#pragma unroll
        for (int i = 0; i < 32; ++i) { const float g0 = lng[k0 + 2 * i], g1 = lng[k0 + 2 * i + 1], b0 = lnb[k0 + 2 * i], b1 = lnb[k0 + 2 * i + 1];
            const float gk = hi ? g1 : g0, bk = hi ? b1 : b0; s2 += wv[i] * bk; wv[i] *= gk; s1 += wv[i]; }
        s1 += bperm_f(lane ^ 32, s1); s2 += bperm_f(lane ^ 32, s2);
        if (hi == 0 && ok) { int drow = nn;
            if (MODE == 1) { const bool up = drow >= DFF; const int f = up ? drow - DFF : drow; drow = 256 * (f >> 7) + (f & 127) + (up ? 128 : 0); }
            c1[(size_t)kb * CP_N + drow] = s1; c2[(size_t)kb * CP_N + drow] = s2; }
    }
#pragma unroll
    for (int i = 0; i < 32; ++i) scr[(2 * i + hi) * 33 + (lane & 31)] = ok ? wv[i] : 0.f;
    LDS_WAIT(); asm volatile("" ::: "memory");
    const int c = lane & 7;
#pragma unroll
    for (int j = 0; j < 4; ++j) { const int n = (lane >> 3) + 8 * j; const LAS float* sp = scr + (8 * c) * 33 + n;
        u32x4 o; o.x = pk2(sp[0 * 33], sp[1 * 33]); o.y = pk2(sp[2 * 33], sp[3 * 33]); o.z = pk2(sp[4 * 33], sp[5 * 33]); o.w = pk2(sp[6 * 33], sp[7 * 33]);
        int drow = n0 + n;
        if (MODE == 1) { const bool up = drow >= DFF; const int f = up ? drow - DFF : drow; drow = 256 * (f >> 7) + (f & 127) + (up ? 128 : 0); }
        if (I8) { u32x2 o8; o8.x = pg8::pk4_i8(sp[0 * 33] * W8I_INV, sp[1 * 33] * W8I_INV, sp[2 * 33] * W8I_INV, sp[3 * 33] * W8I_INV); o8.y = pg8::pk4_i8(sp[4 * 33] * W8I_INV, sp[5 * 33] * W8I_INV, sp[6 * 33] * W8I_INV, sp[7 * 33] * W8I_INV);
            *(GAS u32x2*)((unsigned char*)WT + (size_t)drow * K + k0 + 8 * c) = o8; }
        else if (F8) { u32x2 o8; o8.x = pg8::pk4_fp8(sp[0 * 33] * (float)F8, sp[1 * 33] * (float)F8, sp[2 * 33] * (float)F8, sp[3 * 33] * (float)F8); o8.y = pg8::pk4_fp8(sp[4 * 33] * (float)F8, sp[5 * 33] * (float)F8, sp[6 * 33] * (float)F8, sp[7 * 33] * (float)F8);
            *(GAS u32x2*)((unsigned char*)WT + (size_t)drow * K + k0 + 8 * c) = o8; }
        else *(GAS u32x4*)(WT + (size_t)drow * K + k0 + 8 * c) = o; }
    LDS_WAIT(); asm volatile("" ::: "memory");
}

__device__ __forceinline__ void st_wt16(void* p, f32x4 v) { asm volatile("global_store_dwordx4 %0, %1, off sc1\n\ts_nop 1" :: "v"(p), "v"(v) : "memory"); }
__device__ __forceinline__ void st_wt8(void* p, u32x2 v) { asm volatile("global_store_dwordx2 %0, %1, off sc1\n\ts_nop 1" :: "v"(p), "v"(v) : "memory"); }
__device__ __forceinline__ void st_wt8f(void* p, f32x2 v) { asm volatile("global_store_dwordx2 %0, %1, off sc1\n\ts_nop 1" :: "v"(p), "v"(v) : "memory"); }
__device__ __forceinline__ void st_wt4(void* p, unsigned v) { asm volatile("global_store_dword %0, %1, off sc1\n\ts_nop 1" :: "v"(p), "v"(v) : "memory"); }
template <int MODE>
__device__ __forceinline__ void sample_rows_t(const float* xs, const float* slab, float* Y, bf16_t* TB, float* ST, const float* STin, const float* __restrict__ gin, const float* __restrict__ bin, int gw, int NGW, int lane, unsigned char* T8 = nullptr, float pscale = 1.f) {
#pragma unroll 1
    for (int m = MP + gw; m < M; m += NGW) {
        const size_t ro = (size_t)(m - MP) * DM; const f32x4* rr = (const f32x4*)((MODE == 0 ? xs + ro : Y + (size_t)m * DM)) + lane;
        const u32x2* p0 = (const u32x2*)((const bf16_t*)slab + ro) + lane; const u32x2* p1 = p0 + (size_t)MS * DM / 4; const u32x2* p2 = p1 + (size_t)MS * DM / 4; const u32x2* p3 = p2 + (size_t)MS * DM / 4;
        float mu = 0.f, rs = 1.f; if (MODE == 1) pg8::row_mu_rstd(STin, m, mu, rs);
        f32x4 v[16]; float sm = 0.f, sq = 0.f;
#pragma unroll
        for (int j = 0; j < 16; ++j) { f32x4 r = rr[64 * j];
            if (MODE == 1) r = (r - mu) * rs * ((const f32x4*)gin)[lane + 64 * j] + ((const f32x4*)bin)[lane + 64 * j];
            const u32x2 q0 = p0[64 * j], q1 = p1[64 * j], q2 = p2[64 * j], q3 = p3[64 * j];
            const f32x4 ps = ((f32x4){bf_lo(q0.x), bf_hi(q0.x), bf_lo(q0.y), bf_hi(q0.y)} + (f32x4){bf_lo(q1.x), bf_hi(q1.x), bf_lo(q1.y), bf_hi(q1.y)}) + ((f32x4){bf_lo(q2.x), bf_hi(q2.x), bf_lo(q2.y), bf_hi(q2.y)} + (f32x4){bf_lo(q3.x), bf_hi(q3.x), bf_lo(q3.y), bf_hi(q3.y)});
            v[j] = r * DN_ALPHA + ps * pscale;
            sm += (v[j].x + v[j].y) + (v[j].z + v[j].w); sq += (v[j].x * v[j].x + v[j].y * v[j].y) + (v[j].z * v[j].z + v[j].w * v[j].w);
            if ((j & 1) == 1) asm volatile("" ::: "memory"); }
        sm = wave_sum(sm); sq = wave_sum(sq);
        f32x4* of = (f32x4*)(Y + (size_t)m * DM) + lane; u32x2* ob = (u32x2*)(TB + (size_t)m * DM) + lane;
#pragma unroll
        for (int j = 0; j < 16; ++j) { st_wt16(of + 64 * j, v[j]); u32x2 w; w.x = pk2(v[j].x, v[j].y); w.y = pk2(v[j].z, v[j].w); st_wt8(ob + 64 * j, w);
            if (MODE == 1) st_wt4((unsigned*)(T8 + (size_t)m * DM) + lane + 64 * j, pg8::pk4_fp8(v[j].x, v[j].y, v[j].z, v[j].w));
            else if (T8) st_wt4((unsigned*)(T8 + (size_t)m * DM) + lane + 64 * j, pg8::pk4_i8(v[j].x * A8I_INV, v[j].y * A8I_INV, v[j].z * A8I_INV, v[j].w * A8I_INV)); }
        if (lane == 0) st_wt8f(ST + 2 * (size_t)m, pg8::stats_finalize(sm, sq));
    }
}

__device__ __forceinline__ void prompt_rows_stats(const float* PST, float* ST, int gtid, int gthreads) {
    for (int m = gtid; m < MP; m += gthreads) { const f32x4* p = (const f32x4*)(PST + (size_t)m * 128); float sm = 0.f, sq = 0.f;
#pragma unroll
        for (int j = 0; j < 32; ++j) { const f32x4 v = p[j]; sm += v.x + v.z; sq += v.y + v.w; }
        *(f32x2*)(ST + 2 * (size_t)m) = pg8::stats_finalize(sm, sq); }
}
__device__ __forceinline__ void prompt_rows_stats_w(const float* PST, float* ST, int row0, int lane) {
    f32x2 v[8];
#pragma unroll
    for (int r = 0; r < 8; ++r) v[r] = *(const f32x2*)(PST + (size_t)(row0 + r) * 128 + 2 * lane);
#pragma unroll
    for (int r = 0; r < 8; ++r) { const float sm = wave_sum(v[r].x), sq = wave_sum(v[r].y); if (lane == 0) st_wt8f(ST + 2 * (size_t)(row0 + r), pg8::stats_finalize(sm, sq)); }
}
template <int MODE>
__device__ __forceinline__ void rows_pass(const float* xs, const float* slab, float* Y, bf16_t* TB, const float* PST, float* ST, const float* STin, const float* gin, const float* bin, unsigned* cnt, int vcu, int G, int wave, int lane, unsigned char* T8 = nullptr, float pscale = 1.f) {
    if (wave < 4) sample_rows_t<MODE>(xs, slab, Y, TB, ST, STin, gin, bin, vcu * 4 + wave, G * 4, lane, T8, pscale);
    else { for (int rb = (vcu * 4 + wave - 4) * 8; rb < MP; rb += G * 32) prompt_rows_stats_w(PST, ST, rb, lane); }
    asm volatile("s_waitcnt vmcnt(0)" ::: "memory"); __syncthreads();
    if (wave == 0 && lane == 0) __hip_atomic_fetch_add(cnt, 1u, __ATOMIC_RELAXED, __HIP_MEMORY_SCOPE_AGENT);
}
__device__ __forceinline__ void ln_rows(const float* in, const float* res, const float* slab, float* outf, bf16_t* outb, const float* __restrict__ g, const float* __restrict__ b, int gw, int NGW, int lane) {
#pragma unroll 1
    for (int m = gw; m < M; m += NGW) {
        f32x4 v[16]; float s = 0.f;
        if (m < MP) {
            const f32x4* xr = (const f32x4*)(in + (size_t)m * DM) + lane;
#pragma unroll
            for (int j = 0; j < 16; ++j) v[j] = xr[64 * j];
        } else {
            const size_t ro = (size_t)(m - MP) * DM; const f32x4* rr = (const f32x4*)(res + ro) + lane;
            const f32x4* p0 = (const f32x4*)(slab + ro) + lane; const f32x4* p1 = p0 + (size_t)MS * DM / 4; const f32x4* p2 = p1 + (size_t)MS * DM / 4; const f32x4* p3 = p2 + (size_t)MS * DM / 4;
#pragma unroll
            for (int j = 0; j < 16; ++j) { v[j] = rr[64 * j] * DN_ALPHA + ((p0[64 * j] + p1[64 * j]) + (p2[64 * j] + p3[64 * j])); if ((j & 3) == 3) asm volatile("" ::: "memory"); }
        }
#pragma unroll
        for (int j = 0; j < 16; ++j) { s += (v[j].x + v[j].y) + (v[j].z + v[j].w); }
        const float mean = wave_sum(s) * (1.f / DM); float s2 = 0.f;
#pragma unroll
        for (int j = 0; j < 16; ++j) { v[j] = v[j] - mean; s2 += (v[j].x * v[j].x + v[j].y * v[j].y) + (v[j].z * v[j].z + v[j].w * v[j].w); }
        const float rstd = 1.0f / sqrtf(wave_sum(s2) * (1.f / DM) + LN_EPS);
        f32x4* of = (f32x4*)(outf + (size_t)m * DM) + lane; u32x2* ob = (u32x2*)(outb + (size_t)m * DM) + lane;
#pragma unroll
        for (int j = 0; j < 16; ++j) { const f32x4 gg = ((const f32x4*)g)[lane + 64 * j], bb = ((const f32x4*)b)[lane + 64 * j];
            const f32x4 y = v[j] * rstd * gg + bb; of[64 * j] = y; u32x2 w; w.x = pk2(y.x, y.y); w.y = pk2(y.z, y.w); ob[64 * j] = w;
            if ((j & 3) == 3) asm volatile("" ::: "memory"); }
    }
}

__device__ __forceinline__ void bf8_to_f32(const u32x4 w, float (&f)[8]) {
    f[0] = bf_lo(w.x); f[1] = bf_hi(w.x); f[2] = bf_lo(w.y); f[3] = bf_hi(w.y); f[4] = bf_lo(w.z); f[5] = bf_hi(w.z); f[6] = bf_lo(w.w); f[7] = bf_hi(w.w);
}

typedef float f32x16 __attribute__((ext_vector_type(16)));
typedef __bf16 bf16x2_t __attribute__((ext_vector_type(2)));
#define MFMA32(a, b, c) __builtin_amdgcn_mfma_f32_32x32x16_bf16((a), (b), (c), 0, 0, 0)
__device__ __forceinline__ unsigned cvtpk(float lo, float hi) { f32x2 v = {lo, hi}; bf16x2_t b = __builtin_convertvector(v, bf16x2_t); return __builtin_bit_cast(unsigned, b); }
template <int S> __device__ __forceinline__ bf16x8 pack8(const f32x16& x) {
    u32x4 p; p.x = cvtpk(x[8 * S], x[8 * S + 1]); p.y = cvtpk(x[8 * S + 2], x[8 * S + 3]); p.z = cvtpk(x[8 * S + 4], x[8 * S + 5]); p.w = cvtpk(x[8 * S + 6], x[8 * S + 7]);
    return __builtin_bit_cast(bf16x8, p);
}
__device__ __forceinline__ int crow(int r, int hi) { return (r & 3) + 8 * (r >> 2) + 4 * hi; }

constexpr int SL_KQ = 0, SL_X = 4352, SL_KDT = 8704, SL_U = 10752, SL_AT = 14848, SL_QK = 15104, SL_TT = 15360, SL_TAB = 15616, SL_BYTES = 16384;
__device__ __forceinline__ void sample_task(const float* __restrict__ wconv, const float* __restrict__ sconv, int bidx, const float* __restrict__ BAq, const float* __restrict__ alog, const float* __restrict__ dtb,
                                            const float* __restrict__ S0, float* Sout, const bf16_t* __restrict__ proj, const float* __restrict__ ong, bf16_t* mixed, int row0, int h, LAS unsigned char* wl, int lane) {
    asm volatile("" : "+v"(wl));
    LAS bf16_t* KQ = (LAS bf16_t*)(wl + SL_KQ); LAS bf16_t* X = (LAS bf16_t*)(wl + SL_X); LAS bf16_t* KDT = (LAS bf16_t*)(wl + SL_KDT); LAS float* U = (LAS float*)(wl + SL_U);
    LAS float* AT = (LAS float*)(wl + SL_AT); LAS float* QKm = (LAS float*)(wl + SL_QK); LAS float* TT = (LAS float*)(wl + SL_TT); LAS float* tab = (LAS float*)(wl + SL_TAB);
    LAS float* OS = (LAS float*)(wl + SL_KQ);
    const int l31 = lane & 31, hi = lane >> 5;
    { const int row = lane >> 3, seg = lane & 7;
#pragma unroll
      for (int tn = 0; tn < 3; ++tn) {
          float acc[16];
#pragma unroll
          for (int e = 0; e < 16; ++e) acc[e] = 0.f;
          const int chb = tn * DNW + h * HD + seg * 16;
#pragma unroll
          for (int j = 0; j < 4; ++j) { const int tt = row - 3 + j; float x[16];
              if (tt >= 0) { const bf16_t* p = proj + (size_t)(row0 + tt) * PROJ_LD + O1 + chb; float a8[8], b8[8]; bf8_to_f32(*(const u32x4*)p, a8); bf8_to_f32(*(const u32x4*)(p + 8), b8);
#pragma unroll
                  for (int e = 0; e < 8; ++e) { x[e] = a8[e]; x[8 + e] = b8[e]; } }
              else { const float* sp = sconv + ((size_t)(bidx * 3 + 3 + tt)) * CCH + chb;
#pragma unroll
                  for (int q4 = 0; q4 < 4; ++q4) { const f32x4 t = *(const f32x4*)(sp + 4 * q4); x[4 * q4] = t[0]; x[4 * q4 + 1] = t[1]; x[4 * q4 + 2] = t[2]; x[4 * q4 + 3] = t[3]; } }
              const float* wp = wconv + (size_t)j * CCH + chb;
#pragma unroll
              for (int q4 = 0; q4 < 4; ++q4) { const f32x4 w = *(const f32x4*)(wp + 4 * q4);
#pragma unroll
                  for (int e = 0; e < 4; ++e) acc[4 * q4 + e] += x[4 * q4 + e] * w[e]; } }
          float ss = 0.f;
#pragma unroll
          for (int e = 0; e < 16; ++e) { acc[e] = acc[e] * fast_sigmoid(acc[e]); ss += acc[e] * acc[e]; }
          if (tn < 2) { ss += swz_xor<1>(ss); ss += swz_xor<2>(ss); ss += swz_xor<4>(ss); float rn = __builtin_amdgcn_rsqf(ss + L2_EPS); if (tn == 0) rn *= 0.08838834764831845f;
#pragma unroll
              for (int e = 0; e < 16; ++e) acc[e] *= rn; }
          u32x4 p0, p1; p0.x = pk2(acc[0], acc[1]); p0.y = pk2(acc[2], acc[3]); p0.z = pk2(acc[4], acc[5]); p0.w = pk2(acc[6], acc[7]);
          p1.x = pk2(acc[8], acc[9]); p1.y = pk2(acc[10], acc[11]); p1.z = pk2(acc[12], acc[13]); p1.w = pk2(acc[14], acc[15]);
          LAS bf16_t* dst = (tn == 0 ? KQ + (8 + row) * 136 : tn == 1 ? KQ + row * 136 : X + row * 136) + seg * 16;
          *(LAS u32x4*)dst = p0; *(LAS u32x4*)(dst + 8) = p1;
      } }
    asm volatile("s_waitcnt lgkmcnt(0)" ::: "memory");
    unsigned kc[8], vc[8], qc[8];
#pragma unroll
    for (int j = 0; j < 8; ++j) { kc[j] = *(const LAS unsigned*)(KQ + j * 136 + 2 * lane); qc[j] = *(const LAS unsigned*)(KQ + (8 + j) * 136 + 2 * lane); vc[j] = *(const LAS unsigned*)(X + j * 136 + 2 * lane); }
    if (lane < 16) { const int tr = lane & 7; const float raw = BAq[(size_t)(row0 + tr) * 64 + (lane < 8 ? NH + h : h)];
        float val; if (lane < 8) { const float xx = raw + dtb[h]; val = -expf(alog[h]) * (fmaxf(xx, 0.f) + log1pf(expf(-fabsf(xx)))); } else val = 1.0f / (1.0f + expf(-raw));
        tab[lane] = val; }
    asm volatile("s_waitcnt lgkmcnt(0)" ::: "memory");
    float gc[8], be[8];
    { const f32x4 g0 = *(const LAS f32x4*)(tab), g1 = *(const LAS f32x4*)(tab + 4), b0 = *(const LAS f32x4*)(tab + 8), b1 = *(const LAS f32x4*)(tab + 12);
      gc[0] = g0[0]; gc[1] = gc[0] + g0[1]; gc[2] = gc[1] + g0[2]; gc[3] = gc[2] + g0[3]; gc[4] = gc[3] + g1[0]; gc[5] = gc[4] + g1[1]; gc[6] = gc[5] + g1[2]; gc[7] = gc[6] + g1[3];
      be[0] = b0[0]; be[1] = b0[1]; be[2] = b0[2]; be[3] = b0[3]; be[4] = b1[0]; be[5] = b1[1]; be[6] = b1[2]; be[7] = b1[3]; }
    { f32x16 Dk, Dq;
#pragma unroll
      for (int r = 0; r < 16; ++r) { Dk[r] = 0.f; Dq[r] = 0.f; }
      const int rr = l31 & 7;
#pragma unroll
      for (int s2 = 0; s2 < 8; ++s2) { const bf16x8 kf = *(const LAS bf16x8*)(KQ + rr * 136 + 16 * s2 + 8 * hi), qf = *(const LAS bf16x8*)(KQ + (8 + rr) * 136 + 16 * s2 + 8 * hi);
          Dk = MFMA32(kf, kf, Dk); Dq = MFMA32(qf, kf, Dq); }
      if (l31 < 8) { const int j = l31;
#pragma unroll
          for (int r = 0; r < 4; ++r) { const int i = 4 * hi + r; const float gi = hi ? gc[4 + r] : gc[r], bi = hi ? be[4 + r] : be[r];
              float gj = gc[0];
#pragma unroll
              for (int e = 1; e < 8; ++e) gj = (j == e) ? gc[e] : gj;
              const float dec = __expf(gi - gj);
              AT[j * 8 + i] = (i > j) ? bi * dec * Dk[r] : 0.f; QKm[i * 8 + j] = (i >= j) ? dec * Dq[r] : 0.f; } }
    }
    asm volatile("s_waitcnt lgkmcnt(0)" ::: "memory");
    if (lane < 8) { float T[8];
#pragma unroll
        for (int c = 7; c >= 0; --c) { float a = (lane == c) ? 1.f : 0.f;
#pragma unroll
            for (int j = c + 1; j < 8; ++j) a -= T[j] * AT[c * 8 + j];
            T[c] = a; }
        *(LAS f32x4*)(TT + lane * 8) = (f32x4){T[0], T[1], T[2], T[3]}; *(LAS f32x4*)(TT + lane * 8 + 4) = (f32x4){T[4], T[5], T[6], T[7]}; }
    asm volatile("s_waitcnt lgkmcnt(0)" ::: "memory");
    { float eg[8], ed[8];
#pragma unroll
      for (int i = 0; i < 8; ++i) { eg[i] = __expf(gc[i]); ed[i] = __expf(gc[7] - gc[i]); }
      float vb0[8], vb1[8], kg0[8], kg1[8];
#pragma unroll
      for (int j = 0; j < 8; ++j) { vb0[j] = bf_lo(vc[j]) * be[j]; vb1[j] = bf_hi(vc[j]) * be[j]; const float sc = be[j] * eg[j]; kg0[j] = bf_lo(kc[j]) * sc; kg1[j] = bf_hi(kc[j]) * sc; }
      float kd0[8], kd1[8];
#pragma unroll
      for (int i = 0; i < 8; ++i) {
          const f32x4 t0 = *(const LAS f32x4*)(TT + i * 8), t1 = *(const LAS f32x4*)(TT + i * 8 + 4); const float t[8] = {t0[0], t0[1], t0[2], t0[3], t1[0], t1[1], t1[2], t1[3]};
          float u0 = 0.f, u1 = 0.f, w0 = 0.f, w1 = 0.f;
#pragma unroll
          for (int j = 0; j <= i; ++j) { u0 += t[j] * vb0[j]; u1 += t[j] * vb1[j]; w0 += t[j] * kg0[j]; w1 += t[j] * kg1[j]; }
          *(LAS f32x2*)(U + i * 128 + 2 * lane) = (f32x2){u0, u1};
          *(LAS unsigned*)(X + i * 136 + 2 * lane) = cvtpk(-w0, -w1);
          *(LAS unsigned*)(X + (8 + i) * 136 + 2 * lane) = cvtpk(bf_lo(qc[i]) * eg[i], bf_hi(qc[i]) * eg[i]);
          kd0[i] = bf_lo(kc[i]) * ed[i]; kd1[i] = bf_hi(kc[i]) * ed[i]; }
      u32x4 p0, p1; p0.x = cvtpk(kd0[0], kd0[1]); p0.y = cvtpk(kd0[2], kd0[3]); p0.z = cvtpk(kd0[4], kd0[5]); p0.w = cvtpk(kd0[6], kd0[7]);
      p1.x = cvtpk(kd1[0], kd1[1]); p1.y = cvtpk(kd1[2], kd1[3]); p1.z = cvtpk(kd1[4], kd1[5]); p1.w = cvtpk(kd1[6], kd1[7]);
      *(LAS u32x4*)(KDT + (2 * lane) * 8) = p0; *(LAS u32x4*)(KDT + (2 * lane + 1) * 8) = p1; }
    asm volatile("s_waitcnt lgkmcnt(0)" ::: "memory");
    bf16x8 Xf[8], KDX[4], QKX;
    { const bool act = l31 < 16;
#pragma unroll
      for (int ks = 0; ks < 8; ++ks) { const int k0 = 32 * (ks >> 1) + 16 * (ks & 1) + 4 * hi; u32x4 p = (u32x4){0u, 0u, 0u, 0u};
          if (act) { const u32x2 a = *(const LAS u32x2*)(X + l31 * 136 + k0), b = *(const LAS u32x2*)(X + l31 * 136 + k0 + 8); p.x = a.x; p.y = a.y; p.z = b.x; p.w = b.y; }
          Xf[ks] = __builtin_bit_cast(bf16x8, p); }
#pragma unroll
      for (int kt = 0; kt < 4; ++kt) { const u32x2 a = *(const LAS u32x2*)(KDT + (32 * kt + l31) * 8 + 4 * hi); u32x4 p; p.x = a.x; p.y = a.y; p.z = 0u; p.w = 0u; KDX[kt] = __builtin_bit_cast(bf16x8, p); }
      u32x4 p = (u32x4){0u, 0u, 0u, 0u};
      if (l31 >= 8 && l31 < 16) { const f32x4 qv = *(const LAS f32x4*)(QKm + (l31 - 8) * 8 + 4 * hi); p.x = cvtpk(qv[0], qv[1]); p.y = cvtpk(qv[2], qv[3]); }
      QKX = __builtin_bit_cast(bf16x8, p); }
    const float al = __expf(gc[7]);
#pragma unroll 1
    for (int vt = 0; vt < 4; ++vt) {
        f32x16 S[4];
        const float* sp = S0 + vt * 32 + l31; float* so = Sout + vt * 32 + l31;
#pragma unroll
        for (int kt = 0; kt < 4; ++kt)
#pragma unroll
            for (int r = 0; r < 16; ++r) S[kt][r] = sp[(size_t)(32 * kt + crow(r, hi)) * HD];
        f32x16 D;
#pragma unroll
        for (int r = 0; r < 16; ++r) D[r] = 0.f;
        D = MFMA32(Xf[0], pack8<0>(S[0]), D); D = MFMA32(Xf[1], pack8<1>(S[0]), D); D = MFMA32(Xf[2], pack8<0>(S[1]), D); D = MFMA32(Xf[3], pack8<1>(S[1]), D);
        D = MFMA32(Xf[4], pack8<0>(S[2]), D); D = MFMA32(Xf[5], pack8<1>(S[2]), D); D = MFMA32(Xf[6], pack8<0>(S[3]), D); D = MFMA32(Xf[7], pack8<1>(S[3]), D);
        float vn[4];
#pragma unroll
        for (int r = 0; r < 4; ++r) vn[r] = U[(4 * hi + r) * 128 + vt * 32 + l31] + D[r];
        u32x4 pv; pv.x = cvtpk(vn[0], vn[1]); pv.y = cvtpk(vn[2], vn[3]); pv.z = 0u; pv.w = 0u; const bf16x8 vf = __builtin_bit_cast(bf16x8, pv);
        D = MFMA32(QKX, vf, D);
#pragma unroll
        for (int kt = 0; kt < 4; ++kt) { S[kt] = S[kt] * al; S[kt] = MFMA32(KDX[kt], vf, S[kt]); }
#pragma unroll
        for (int r = 0; r < 4; ++r) OS[(4 * hi + r) * 132 + vt * 32 + l31] = D[4 + r];
#pragma unroll
        for (int kt = 0; kt < 4; ++kt)
#pragma unroll
            for (int r = 0; r < 16; ++r) so[(size_t)(32 * kt + crow(r, hi)) * HD] = S[kt][r];
    }
    asm volatile("s_waitcnt lgkmcnt(0)" ::: "memory");
    { const int r = lane >> 3, sg = lane & 7; float o[16];
#pragma unroll
      for (int q4 = 0; q4 < 4; ++q4) { const f32x4 t = *(const LAS f32x4*)(OS + r * 132 + sg * 16 + 4 * q4); o[4 * q4] = t[0]; o[4 * q4 + 1] = t[1]; o[4 * q4 + 2] = t[2]; o[4 * q4 + 3] = t[3]; }
      float ss = 0.f;
#pragma unroll
      for (int e = 0; e < 16; ++e) ss += o[e] * o[e];
      ss += swz_xor<1>(ss); ss += swz_xor<2>(ss); ss += swz_xor<4>(ss);
      const float rn = __builtin_amdgcn_rsqf(ss * (1.0f / HD) + RMS_EPS);
      const bf16_t* zp = proj + (size_t)(row0 + r) * PROJ_LD + O2 + h * HD + sg * 16; float z[16]; { float t8[8]; bf8_to_f32(*(const u32x4*)zp, t8);
#pragma unroll
          for (int e = 0; e < 8; ++e) z[e] = t8[e];
          bf8_to_f32(*(const u32x4*)(zp + 8), t8);
#pragma unroll
          for (int e = 0; e < 8; ++e) z[8 + e] = t8[e]; }
      unsigned w[8];
#pragma unroll
      for (int e = 0; e < 16; e += 2) { const float a = o[e] * rn * ong[sg * 16 + e] * (z[e] * fast_sigmoid(z[e])), c = o[e + 1] * rn * ong[sg * 16 + e + 1] * (z[e + 1] * fast_sigmoid(z[e + 1])); w[e >> 1] = pk2(a, c); }
      bf16_t* mp = mixed + (size_t)(row0 + r) * DM + PW + h * HD + sg * 16;
      *(u32x4*)mp = (u32x4){w[0], w[1], w[2], w[3]}; *(u32x4*)(mp + 8) = (u32x4){w[4], w[5], w[6], w[7]}; }
    asm volatile("s_waitcnt lgkmcnt(0)" ::: "memory");
}

constexpr int G1L_QB = 0, G1L_KB = 17408, G1L_KT = 34816, G1L_KGT = 53248, G1L_VBT = 71680, G1L_AT = 90112, G1L_TB = 107520, G1L_TAB = 116736, G1L_TM = 118016  , G1L_MS = 135424  ;
__device__ __forceinline__ f32x16 tile_chain(const LAS bf16_t* A, int lda, const LAS bf16_t* B, int ldb, int nsteps, int l31, int hi) {
    f32x16 acc;
#pragma unroll
    for (int r = 0; r < 16; ++r) acc[r] = 0.f;
#pragma unroll
    for (int s = 0; s < 8; ++s) if (s < nsteps) { const bf16x8 a = *(const LAS bf16x8*)(A + l31 * lda + 16 * s + 8 * hi), b = *(const LAS bf16x8*)(B + l31 * ldb + 16 * s + 8 * hi); acc = MFMA32(a, b, acc); }
    return acc;
}
__device__ __forceinline__ void g1_chunk(const bf16_t* __restrict__ proj, const float* __restrict__ wconv, const float* __restrict__ BAq, const float* __restrict__ alog, const float* __restrict__ dtb,
                                         unsigned char* cb, float* glast_out, int r0, int t0, int h, LAS unsigned char* lds, int wave, int lane, int r0n, int hn) {
    asm volatile("" : "+v"(lds));
    asm volatile("" : "+v"(lane));
    LAS bf16_t* qB = (LAS bf16_t*)(lds + G1L_QB); LAS bf16_t* kB = (LAS bf16_t*)(lds + G1L_KB); LAS bf16_t* kT = (LAS bf16_t*)(lds + G1L_KT);
    LAS bf16_t* kgT = (LAS bf16_t*)(lds + G1L_KGT); LAS bf16_t* vbT = (LAS bf16_t*)(lds + G1L_VBT); LAS float* AT = (LAS float*)(lds + G1L_AT);
    LAS bf16_t* TB = (LAS bf16_t*)(lds + G1L_TB); LAS float* tab = (LAS float*)(lds + G1L_TAB);
    LAS bf16_t* vB = (LAS bf16_t*)(lds + G1L_TM);
    LAS float* wcv = (LAS float*)(lds + G1L_MS);
    LAS float* t_gc = tab; LAS float* t_be = tab + 64; LAS float* t_eg = tab + 128; LAS float* t_ed = tab + 192; LAS float* t_sc = tab + 256;
    const int tid = wave * 64 + lane, l31 = lane & 31, hi = lane >> 5;
    const int row = tid >> 3, seg = tid & 7;
    u32x4 raw[3][4][2];
#pragma unroll
    for (int tn = 0; tn < 3; ++tn)
#pragma unroll
        for (int j = 0; j < 4; ++j) { const int tt = t0 + row - 3 + j;
            raw[tn][j][0] = (u32x4){0u, 0u, 0u, 0u}; raw[tn][j][1] = raw[tn][j][0];
            if (tt >= 0) { const bf16_t* p = proj + (size_t)(r0 + row - 3 + j) * PROJ_LD + O1 + tn * DNW + h * HD + seg * 16; raw[tn][j][0] = *(const u32x4*)p; raw[tn][j][1] = *(const u32x4*)(p + 8); } }
    if (tid < 384) { const int wr_ = tid >> 5, c4 = tid & 31, tn = wr_ >> 2, j = wr_ & 3;
        *(LAS f32x4*)(wcv + wr_ * 128 + c4 * 4) = *(const f32x4*)(wconv + (size_t)j * CCH + tn * DNW + h * HD + c4 * 4); }
    float gq = 0.f, beq = 0.f;
    if (wave == 0) { const float braw = BAq[(size_t)(r0 + lane) * 64 + h], araw = BAq[(size_t)(r0 + lane) * 64 + NH + h]; const float xx = araw + dtb[h];
        gq = -expf(alog[h]) * (fmaxf(xx, 0.f) + log1pf(expf(-fabsf(xx)))); beq = 1.0f / (1.0f + expf(-braw)); }
    __syncthreads();
#pragma unroll
    for (int tn = 0; tn < 3; ++tn) {
        float acc[16];
#pragma unroll
        for (int e = 0; e < 16; ++e) acc[e] = 0.f;
#pragma unroll
        for (int j = 0; j < 4; ++j) { float x0[8], x1[8]; bf8_to_f32(raw[tn][j][0], x0); bf8_to_f32(raw[tn][j][1], x1);
            const LAS f32x4* wp = (const LAS f32x4*)(wcv + (tn * 4 + j) * 128 + seg * 16); const f32x4 w0 = wp[0], w1 = wp[1], w2 = wp[2], w3 = wp[3];
#pragma unroll
            for (int e = 0; e < 4; ++e) { acc[e] += x0[e] * w0[e]; acc[4 + e] += x0[4 + e] * w1[e]; acc[8 + e] += x1[e] * w2[e]; acc[12 + e] += x1[4 + e] * w3[e]; } }
        float ss = 0.f;
#pragma unroll
        for (int e = 0; e < 16; ++e) { acc[e] = acc[e] * fast_sigmoid(acc[e]); ss += acc[e] * acc[e]; }
        if (tn < 2) { ss += swz_xor<1>(ss); ss += swz_xor<2>(ss); ss += swz_xor<4>(ss); float rn = __builtin_amdgcn_rsqf(ss + L2_EPS); if (tn == 0) rn *= 0.08838834764831845f;
#pragma unroll
            for (int e = 0; e < 16; ++e) acc[e] *= rn; }
        u32x4 p0, p1; p0.x = pk2(acc[0], acc[1]); p0.y = pk2(acc[2], acc[3]); p0.z = pk2(acc[4], acc[5]); p0.w = pk2(acc[6], acc[7]);
        p1.x = pk2(acc[8], acc[9]); p1.y = pk2(acc[10], acc[11]); p1.z = pk2(acc[12], acc[13]); p1.w = pk2(acc[14], acc[15]);
        LAS bf16_t* dst = (tn == 0 ? qB : tn == 1 ? kB : vB) + row * 136 + seg * 16;
        *(LAS u32x4*)dst = p0; *(LAS u32x4*)(dst + 8) = p1;
    }
    if (wave == 0) {
        float x = gq; const float be = beq;
        int ls = lane; asm volatile("" : "+v"(ls));
#pragma unroll
        for (int off = 1; off < 64; off <<= 1) { const float y = bperm_f((ls - off) & 63, x); if (ls >= off) x += y; }
        const float gl = bperm_f(63, x);
        const float eg = __expf(x);
        t_gc[lane] = x; t_be[lane] = be; t_eg[lane] = eg; t_ed[lane] = __expf(gl - x); t_sc[lane] = be * eg;
        if (lane == 63) *glast_out = eg;
    }
    __syncthreads();
    unsigned pf0 = 0u, pf1 = 0u, pf2 = 0u;
    if (r0n >= 0) { const unsigned* pp = (const unsigned*)(proj + (size_t)(r0n + row) * PROJ_LD + O1 + hn * HD + seg * 16);
        pf0 = pp[0]; pf1 = pp[DNW / 2]; pf2 = pp[DNW]; }
    { const int tc = tid & 127, rg = tid >> 7;
      unsigned kraw[16], vraw[16];
#pragma unroll
      for (int i = 0; i < 16; ++i) { kraw[i] = kB[(16 * rg + i) * 136 + tc]; vraw[i] = vB[(16 * rg + i) * 136 + tc]; }
      { u32x4 a, b; a.x = kraw[0] | (kraw[1] << 16); a.y = kraw[2] | (kraw[3] << 16); a.z = kraw[4] | (kraw[5] << 16); a.w = kraw[6] | (kraw[7] << 16);
        b.x = kraw[8] | (kraw[9] << 16); b.y = kraw[10] | (kraw[11] << 16); b.z = kraw[12] | (kraw[13] << 16); b.w = kraw[14] | (kraw[15] << 16);
        *(LAS u32x4*)(kT + tc * 72 + rg * 16) = a; *(LAS u32x4*)(kT + tc * 72 + rg * 16 + 8) = b; }
      float kf[16], vf[16];
#pragma unroll
      for (int i = 0; i < 16; ++i) { kf[i] = __builtin_bit_cast(float, kraw[i] << 16) * t_sc[16 * rg + i]; vf[i] = __builtin_bit_cast(float, vraw[i] << 16) * t_be[16 * rg + i]; }
      u32x4 a, b; a.x = cvtpk(kf[0], kf[1]); a.y = cvtpk(kf[2], kf[3]); a.z = cvtpk(kf[4], kf[5]); a.w = cvtpk(kf[6], kf[7]); b.x = cvtpk(kf[8], kf[9]); b.y = cvtpk(kf[10], kf[11]); b.z = cvtpk(kf[12], kf[13]); b.w = cvtpk(kf[14], kf[15]);
      *(LAS u32x4*)(kgT + tc * 72 + rg * 16) = a; *(LAS u32x4*)(kgT + tc * 72 + rg * 16 + 8) = b;
      a.x = cvtpk(vf[0], vf[1]); a.y = cvtpk(vf[2], vf[3]); a.z = cvtpk(vf[4], vf[5]); a.w = cvtpk(vf[6], vf[7]); b.x = cvtpk(vf[8], vf[9]); b.y = cvtpk(vf[10], vf[11]); b.z = cvtpk(vf[12], vf[13]); b.w = cvtpk(vf[14], vf[15]);
      *(LAS u32x4*)(vbT + tc * 72 + rg * 16) = a; *(LAS u32x4*)(vbT + tc * 72 + rg * 16 + 8) = b; }
    __syncthreads();
    if (wave < 3) {
        const int jt = wave == 0 ? 0 : 1, ct = wave == 2 ? 1 : 0;
        const f32x16 D = tile_chain(kB + 32 * jt * 136, 136, kB + 32 * ct * 136, 136, 8, l31, hi);
        const int c = 32 * ct + l31; const float gcc = t_gc[c];
#pragma unroll
        for (int g4 = 0; g4 < 4; ++g4) { const int j0 = 32 * jt + 8 * g4 + 4 * hi; const f32x4 gj = *(const LAS f32x4*)(t_gc + j0), bj = *(const LAS f32x4*)(t_be + j0); f32x4 o;
#pragma unroll
            for (int e = 0; e < 4; ++e) o[e] = (j0 + e > c) ? bj[e] * __expf(gj[e] - gcc) * D[4 * g4 + e] : 0.f;
            *(LAS f32x4*)(AT + c * 68 + j0) = o; }
    } else if (wave < 6) {
        const int jt = wave == 5 ? 1 : 0, it = wave == 3 ? 0 : 1;
        const f32x16 D = tile_chain(kB + 32 * jt * 136, 136, qB + 32 * it * 136, 136, 8, l31, hi);
        const int i = 32 * it + l31; const float gci = t_gc[i]; f32x16 P;
#pragma unroll
        for (int g4 = 0; g4 < 4; ++g4) { const int j0 = 32 * jt + 8 * g4 + 4 * hi; const f32x4 gj = *(const LAS f32x4*)(t_gc + j0);
#pragma unroll
            for (int e = 0; e < 4; ++e) P[4 * g4 + e] = (i >= j0 + e) ? __expf(gci - gj[e]) * D[4 * g4 + e] : 0.f; }
        bf16x8* dst = (bf16x8*)(cb + G1_QKF) + lane;
        dst[(it * 2 + 2 * jt) * 64] = pack8<0>(P); dst[(it * 2 + 2 * jt + 1) * 64] = pack8<1>(P);
    } else if (wave == 6) {
        bf16x8* dst = (bf16x8*)(cb + G1_QGF) + lane;
#pragma unroll
        for (int ct = 0; ct < 2; ++ct) { const int c = 32 * ct + l31; const float eg = t_eg[c];
#pragma unroll
            for (int ks = 0; ks < 8; ++ks) { const int k0 = 32 * (ks >> 1) + 16 * (ks & 1) + 4 * hi; const u32x2 a = *(const LAS u32x2*)(qB + c * 136 + k0), b = *(const LAS u32x2*)(qB + c * 136 + k0 + 8);
                u32x4 p; p.x = cvtpk(bf_lo(a.x) * eg, bf_hi(a.x) * eg); p.y = cvtpk(bf_lo(a.y) * eg, bf_hi(a.y) * eg); p.z = cvtpk(bf_lo(b.x) * eg, bf_hi(b.x) * eg); p.w = cvtpk(bf_lo(b.y) * eg, bf_hi(b.y) * eg);
                dst[(ct * 8 + ks) * 64] = __builtin_bit_cast(bf16x8, p); } }
    } else {
        bf16x8* dst = (bf16x8*)(cb + G1_KDF) + lane;
#pragma unroll
        for (int cs = 0; cs < 4; ++cs) { const int c0 = 32 * (cs >> 1) + 16 * (cs & 1) + 4 * hi; const f32x4 e0 = *(const LAS f32x4*)(t_ed + c0), e1 = *(const LAS f32x4*)(t_ed + c0 + 8);
#pragma unroll
            for (int kt = 0; kt < 4; ++kt) { const int k = 32 * kt + l31; const u32x2 a = *(const LAS u32x2*)(kT + k * 72 + c0), b = *(const LAS u32x2*)(kT + k * 72 + c0 + 8);
                u32x4 p; p.x = cvtpk(bf_lo(a.x) * e0[0], bf_hi(a.x) * e0[1]); p.y = cvtpk(bf_lo(a.y) * e0[2], bf_hi(a.y) * e0[3]); p.z = cvtpk(bf_lo(b.x) * e1[0], bf_hi(b.x) * e1[1]); p.w = cvtpk(bf_lo(b.y) * e1[2], bf_hi(b.y) * e1[3]);
                dst[(kt * 4 + cs) * 64] = __builtin_bit_cast(bf16x8, p); } }
    }
    __syncthreads();
    {
        LAS float* at = AT; asm volatile("" : "+v"(at));
        LAS float* Tm = (LAS float*)(lds + G1L_TM); LAS float* Ms = (LAS float*)(lds + G1L_MS) + wave * 320;
        if (wave == 0) {
            const int bb = lane >> 4, r = lane & 15; int rr = r; asm volatile("" : "+v"(rr));
            const LAS float* ab = at + (16 * bb) * 68 + 16 * bb;
            float T[16];
#pragma unroll
            for (int c = 15; c >= 0; --c) {
                float a0 = (rr == c) ? 1.f : 0.f, a1 = 0.f, a2 = 0.f, a3 = 0.f;
#pragma unroll
                for (int j4 = ((c + 1) & ~3); j4 < 16; j4 += 4) {
                    const f32x4 a4 = *(const LAS f32x4*)(ab + c * 68 + j4);
                    if (j4 + 0 > c) a0 -= T[j4 + 0] * a4[0];
                    if (j4 + 1 > c) a1 -= T[j4 + 1] * a4[1];
                    if (j4 + 2 > c) a2 -= T[j4 + 2] * a4[2];
                    if (j4 + 3 > c) a3 -= T[j4 + 3] * a4[3];
                }
                T[c] = (a0 + a1) + (a2 + a3);
            }
            LAS float* td = Tm + (16 * bb + r) * 68 + 16 * bb;
#pragma unroll
            for (int q = 0; q < 4; ++q) *(LAS f32x4*)(td + 4 * q) = (f32x4){T[4 * q], T[4 * q + 1], T[4 * q + 2], T[4 * q + 3]};
        }
        __syncthreads();
        const int lr = lane & 15, lq = lane >> 4;
#define G1_MM(acc, xp, xsr, xsq, yp, ysq) do { _Pragma("unroll") for (int s_ = 0; s_ < 4; ++s_) { const int q_ = 4 * s_ + lq; \
            acc = __builtin_amdgcn_mfma_f32_16x16x4f32((xp)[lr * (xsr) + q_ * (xsq)], (yp)[q_ * (ysq) + lr], acc, 0, 0, 0); } } while (0)
#pragma unroll
        for (int lev = 1; lev <= 3; ++lev) {
            if (wave < 4 - lev) {
                const int bj = wave, bi = wave + lev;
                f32x4 m = (f32x4){0.f, 0.f, 0.f, 0.f};
#pragma unroll
                for (int dk = 0; dk < 3; ++dk) if (dk < lev) { const int bk = bj + dk;
                    const LAS float* xp = at + (16 * bk) * 68 + 16 * bi; const LAS float* yp = Tm + (16 * bk) * 68 + 16 * bj;
                    G1_MM(m, xp, 1, 68, yp, 68); }
#pragma unroll
                for (int e = 0; e < 4; ++e) Ms[(4 * lq + e) * 20 + lr] = m[e];
                asm volatile("s_waitcnt lgkmcnt(0)" ::: "memory");
                f32x4 t = (f32x4){0.f, 0.f, 0.f, 0.f};
                { const LAS float* xp = Tm + (16 * bi) * 68 + 16 * bi; G1_MM(t, xp, 68, 1, Ms, 20); }
#pragma unroll
                for (int e = 0; e < 4; ++e) Tm[(16 * bi + 4 * lq + e) * 68 + 16 * bj + lr] = -t[e];
            }
            __syncthreads();
        }
#undef G1_MM
        { const int row = tid >> 3, c8 = (tid & 7) * 8; u32x4 p = (u32x4){0u, 0u, 0u, 0u};
          if ((c8 >> 4) <= (row >> 4)) { const f32x4 a = *(const LAS f32x4*)(Tm + row * 68 + c8), b = *(const LAS f32x4*)(Tm + row * 68 + c8 + 4);
              p.x = cvtpk(a[0], a[1]); p.y = cvtpk(a[2], a[3]); p.z = cvtpk(b[0], b[1]); p.w = cvtpk(b[2], b[3]); }
          *(LAS u32x4*)(TB + row * 72 + c8) = p; }
    }
    __syncthreads();
    { const int it = wave >> 2, vt = wave & 3;
      const f32x16 D = tile_chain(TB + 32 * it * 72, 72, vbT + 32 * vt * 72, 72, 4, l31, hi);
      bf16x8* dst = (bf16x8*)(cb + G1_UF) + lane;
      dst[((vt * 2 + it) * 2) * 64] = pack8<0>(D); dst[((vt * 2 + it) * 2 + 1) * 64] = pack8<1>(D); }
    { const int kt = wave >> 1, it = wave & 1;
      f32x16 D = tile_chain(kgT + 32 * kt * 72, 72, TB + 32 * it * 72, 72, 4, l31, hi);
#pragma unroll
      for (int r = 0; r < 16; ++r) D[r] = -D[r];
      bf16x8* dst = (bf16x8*)(cb + G1_WF) + lane;
      dst[(it * 8 + 2 * kt) * 64] = pack8<0>(D); dst[(it * 8 + 2 * kt + 1) * 64] = pack8<1>(D); }
    asm volatile("" :: "v"(pf0), "v"(pf1), "v"(pf2));
    __syncthreads();
}

constexpr int G2_FRAG_BYTES = G1_CHUNK_BYTES, G2_OST = 2 * G2_FRAG_BYTES, G2_OLD = 136;
template <int NP>
__device__ __forceinline__ void g2_load_z(u32x4 (&zz)[NP], const bf16_t* __restrict__ proj, int row0g, int h, int rbase, int lane) {
    const int cg = lane & 15, rs = lane >> 4;
#pragma unroll
    for (int p = 0; p < NP; ++p) { const int r = rbase + 4 * p + rs; zz[p] = *(const u32x4*)(proj + (size_t)(row0g + r) * PROJ_LD + O2 + h * HD + cg * 8); }
}
template <int NP>
__device__ __forceinline__ void g2_norm_rows(const LAS bf16_t* ost, const u32x4 (&zz)[NP], const f32x4 g0, const f32x4 g1, bf16_t* mixed, int row0g, int h, int rbase, int lane) {
    const int cg = lane & 15, rs = lane >> 4;
#pragma unroll
    for (int p = 0; p < NP; ++p) { const int r = rbase + 4 * p + rs;
        float a[8]; bf8_to_f32(*(const LAS u32x4*)(ost + r * G2_OLD + cg * 8), a);
        float ss = (a[0] * a[0] + a[1] * a[1]) + (a[2] * a[2] + a[3] * a[3]) + (a[4] * a[4] + a[5] * a[5]) + (a[6] * a[6] + a[7] * a[7]);
        ss = sum16(ss); const float rn = __builtin_amdgcn_rsqf(ss * (1.0f / HD) + RMS_EPS);
        float z[8]; bf8_to_f32(zz[p], z);
        float o[8] = {a[0] * g0[0], a[1] * g0[1], a[2] * g0[2], a[3] * g0[3], a[4] * g1[0], a[5] * g1[1], a[6] * g1[2], a[7] * g1[3]};
#pragma unroll
        for (int e = 0; e < 8; ++e) o[e] = o[e] * rn * (z[e] * fast_sigmoid(z[e]));
        u32x4 w; w.x = pk2(o[0], o[1]); w.y = pk2(o[2], o[3]); w.z = pk2(o[4], o[5]); w.w = pk2(o[6], o[7]);
        *(u32x4*)(mixed + (size_t)(row0g + r) * DM + PW + h * HD + cg * 8) = w; }
}
__device__ __forceinline__ void g2_wg(const unsigned char* __restrict__ g1o, const float* __restrict__ glast, const bf16_t* __restrict__ proj, const float* __restrict__ ong, bf16_t* mixed, float* Sout,
                                      int bh, LAS unsigned char* lds, int wave, int lane) {
    const int l31 = lane & 31, hi = lane >> 5, b = bh / NH, h = bh % NH;
    const unsigned char* cb0 = g1o + (size_t)(bh * 32) * G1_CHUNK_BYTES;
    LAS bf16_t* ost = (LAS bf16_t*)(lds + G2_OST);
#define G2_BAR() do { asm volatile("" ::: "memory"); __builtin_amdgcn_s_barrier(); asm volatile("" ::: "memory"); } while (0)
#define G2_DMA(srcp, dstp) do { _Pragma("unroll") for (int p_ = 0; p_ < 35; ++p_) { const int piece_ = lw + 2 * p_; \
        __builtin_amdgcn_global_load_lds((const unsigned*)((srcp) + piece_ * 1024), (LAS unsigned*)((dstp) + piece_ * 1024), 16, 0, 0); } } while (0)
    if (wave >= 6) {
        const int nw = 32 + 16 * (wave - 6); const int cg = lane & 15;
        const f32x4 g0 = *(const f32x4*)(ong + cg * 8), g1 = *(const f32x4*)(ong + cg * 8 + 4);
        u32x4 zz[4];
        g2_load_z<4>(zz, proj, b * SEQ, h, nw, lane);
#pragma unroll 1
        for (int n = 0; n < 32; ++n) {
            G2_BAR();
            if (n > 0) { g2_norm_rows<4>(ost, zz, g0, g1, mixed, b * SEQ + (n - 1) * 64, h, nw, lane); g2_load_z<4>(zz, proj, b * SEQ + n * 64, h, nw, lane); }
            asm volatile("s_waitcnt lgkmcnt(0)" ::: "memory");
            G2_BAR();
        }
        G2_BAR();
        g2_norm_rows<4>(ost, zz, g0, g1, mixed, b * SEQ + 31 * 64, h, nw, lane);
        return;
    }
    if (wave >= 4) {
        const int lw = wave - 4; const int nw = 16 * lw; const int cg = lane & 15;
        const f32x4 g0 = *(const f32x4*)(ong + cg * 8), g1 = *(const f32x4*)(ong + cg * 8 + 4);
        u32x4 zz[4];
        { const unsigned char* src = cb0 + lane * 16; G2_DMA(src, lds); }
        g2_load_z<4>(zz, proj, b * SEQ, h, nw, lane);
#pragma unroll 1
        for (int n = 0; n < 32; ++n) {
            asm volatile("s_waitcnt vmcnt(0)" ::: "memory");
#pragma unroll
            for (int p = 0; p < 4; ++p) asm volatile("" : "+v"(zz[p]));
            G2_BAR();
            if (n + 1 < 32) { const unsigned char* src = cb0 + (size_t)(n + 1) * G1_CHUNK_BYTES + lane * 16; LAS unsigned char* dst = lds + ((n + 1) & 1) * G2_FRAG_BYTES; G2_DMA(src, dst); }
            if (n > 0) { g2_norm_rows<4>(ost, zz, g0, g1, mixed, b * SEQ + (n - 1) * 64, h, nw, lane); g2_load_z<4>(zz, proj, b * SEQ + n * 64, h, nw, lane); }
            asm volatile("s_waitcnt lgkmcnt(0)" ::: "memory");
            G2_BAR();
        }
        G2_BAR();
        g2_norm_rows<4>(ost, zz, g0, g1, mixed, b * SEQ + 31 * 64, h, nw, lane);
        return;
    }
    const int vt = wave;
    f32x16 S[4];
#pragma unroll
    for (int kt = 0; kt < 4; ++kt)
#pragma unroll
        for (int r = 0; r < 16; ++r) S[kt][r] = 0.f;
    const float alv = glast[bh * 32 + l31];
    bf16x8 Id[2];
#pragma unroll
    for (int s2 = 0; s2 < 2; ++s2) { u32x4 p;
        unsigned e[8];
#pragma unroll
        for (int j = 0; j < 8; ++j) e[j] = ((16 * s2 + 8 * (j >> 2) + 4 * hi + (j & 3)) == l31) ? 0x3F80u : 0u;
        p.x = e[0] | (e[1] << 16); p.y = e[2] | (e[3] << 16); p.z = e[4] | (e[5] << 16); p.w = e[6] | (e[7] << 16); Id[s2] = __builtin_bit_cast(bf16x8, p); }
#pragma unroll 1
    for (int n = 0; n < 32; ++n) {
        const float al = __builtin_bit_cast(float, __builtin_amdgcn_readlane(__builtin_bit_cast(int, alv), n));
        G2_BAR();
        const LAS bf16x8* F = (const LAS bf16x8*)(lds + (n & 1) * G2_FRAG_BYTES) + lane;
        f32x16 vn[2], o[2];
#pragma unroll
        for (int ct = 0; ct < 2; ++ct)
#pragma unroll
            for (int r = 0; r < 16; ++r) { vn[ct][r] = 0.f; o[ct][r] = 0.f; }
        bf16x8 fq[4]; bf16x8 vb[4]; bf16x8 sbc;
        fq[0] = F[(54 + (vt * 2 + 0) * 2 + 0) * 64];
        fq[1] = F[(54 + (vt * 2 + 0) * 2 + 1) * 64];
        fq[2] = F[(54 + (vt * 2 + 1) * 2 + 0) * 64];
        fq[3] = F[(54 + (vt * 2 + 1) * 2 + 1) * 64];
        __builtin_amdgcn_sched_barrier(0);
        vn[0] = MFMA32(Id[0], fq[0], vn[0]); fq[0] = F[(0) * 64]; __builtin_amdgcn_sched_barrier(0);
        vn[0] = MFMA32(Id[1], fq[1], vn[0]); fq[1] = F[(16) * 64]; __builtin_amdgcn_sched_barrier(0);
        vn[1] = MFMA32(Id[0], fq[2], vn[1]); fq[2] = F[(8) * 64]; __builtin_amdgcn_sched_barrier(0);
        vn[1] = MFMA32(Id[1], fq[3], vn[1]); fq[3] = F[(24) * 64]; __builtin_amdgcn_sched_barrier(0);
        sbc = pack8<0>(S[0]);
        vn[0] = MFMA32(fq[0], sbc, vn[0]); fq[0] = F[(1) * 64]; __builtin_amdgcn_sched_barrier(0);
        o[0] = MFMA32(fq[1], sbc, o[0]); fq[1] = F[(17) * 64]; __builtin_amdgcn_sched_barrier(0); asm volatile("" : "+v"(vn[0]), "+v"(o[0]));
        vn[1] = MFMA32(fq[2], sbc, vn[1]); fq[2] = F[(9) * 64]; __builtin_amdgcn_sched_barrier(0);
        o[1] = MFMA32(fq[3], sbc, o[1]); fq[3] = F[(25) * 64]; __builtin_amdgcn_sched_barrier(0); asm volatile("" : "+v"(vn[1]), "+v"(o[1]));
        sbc = pack8<1>(S[0]);
        vn[0] = MFMA32(fq[0], sbc, vn[0]); fq[0] = F[(2) * 64]; __builtin_amdgcn_sched_barrier(0);
        o[0] = MFMA32(fq[1], sbc, o[0]); fq[1] = F[(18) * 64]; __builtin_amdgcn_sched_barrier(0); asm volatile("" : "+v"(vn[0]), "+v"(o[0]));
        vn[1] = MFMA32(fq[2], sbc, vn[1]); fq[2] = F[(10) * 64]; __builtin_amdgcn_sched_barrier(0);
        o[1] = MFMA32(fq[3], sbc, o[1]); fq[3] = F[(26) * 64]; __builtin_amdgcn_sched_barrier(0); asm volatile("" : "+v"(vn[1]), "+v"(o[1]));
        sbc = pack8<0>(S[1]);
        vn[0] = MFMA32(fq[0], sbc, vn[0]); fq[0] = F[(3) * 64]; __builtin_amdgcn_sched_barrier(0);
        o[0] = MFMA32(fq[1], sbc, o[0]); fq[1] = F[(19) * 64]; __builtin_amdgcn_sched_barrier(0); asm volatile("" : "+v"(vn[0]), "+v"(o[0]));
        vn[1] = MFMA32(fq[2], sbc, vn[1]); fq[2] = F[(11) * 64]; __builtin_amdgcn_sched_barrier(0);
        o[1] = MFMA32(fq[3], sbc, o[1]); fq[3] = F[(27) * 64]; __builtin_amdgcn_sched_barrier(0); asm volatile("" : "+v"(vn[1]), "+v"(o[1]));
        sbc = pack8<1>(S[1]);
        vn[0] = MFMA32(fq[0], sbc, vn[0]); fq[0] = F[(4) * 64]; __builtin_amdgcn_sched_barrier(0);
        o[0] = MFMA32(fq[1], sbc, o[0]); fq[1] = F[(20) * 64]; __builtin_amdgcn_sched_barrier(0); asm volatile("" : "+v"(vn[0]), "+v"(o[0]));
        vn[1] = MFMA32(fq[2], sbc, vn[1]); fq[2] = F[(12) * 64]; __builtin_amdgcn_sched_barrier(0);
        o[1] = MFMA32(fq[3], sbc, o[1]); fq[3] = F[(28) * 64]; __builtin_amdgcn_sched_barrier(0); asm volatile("" : "+v"(vn[1]), "+v"(o[1]));
        sbc = pack8<0>(S[2]);
        vn[0] = MFMA32(fq[0], sbc, vn[0]); fq[0] = F[(5) * 64]; __builtin_amdgcn_sched_barrier(0);
        o[0] = MFMA32(fq[1], sbc, o[0]); fq[1] = F[(21) * 64]; __builtin_amdgcn_sched_barrier(0); asm volatile("" : "+v"(vn[0]), "+v"(o[0]));
        vn[1] = MFMA32(fq[2], sbc, vn[1]); fq[2] = F[(13) * 64]; __builtin_amdgcn_sched_barrier(0);
        o[1] = MFMA32(fq[3], sbc, o[1]); fq[3] = F[(29) * 64]; __builtin_amdgcn_sched_barrier(0); asm volatile("" : "+v"(vn[1]), "+v"(o[1]));
        sbc = pack8<1>(S[2]);
        vn[0] = MFMA32(fq[0], sbc, vn[0]); fq[0] = F[(6) * 64]; __builtin_amdgcn_sched_barrier(0);
        o[0] = MFMA32(fq[1], sbc, o[0]); fq[1] = F[(22) * 64]; __builtin_amdgcn_sched_barrier(0); asm volatile("" : "+v"(vn[0]), "+v"(o[0]));
        vn[1] = MFMA32(fq[2], sbc, vn[1]); fq[2] = F[(14) * 64]; __builtin_amdgcn_sched_barrier(0);
        o[1] = MFMA32(fq[3], sbc, o[1]); fq[3] = F[(30) * 64]; __builtin_amdgcn_sched_barrier(0); asm volatile("" : "+v"(vn[1]), "+v"(o[1]));
        sbc = pack8<0>(S[3]);
        vn[0] = MFMA32(fq[0], sbc, vn[0]); fq[0] = F[(7) * 64]; __builtin_amdgcn_sched_barrier(0);
        o[0] = MFMA32(fq[1], sbc, o[0]); fq[1] = F[(23) * 64]; __builtin_amdgcn_sched_barrier(0); asm volatile("" : "+v"(vn[0]), "+v"(o[0]));
        vn[1] = MFMA32(fq[2], sbc, vn[1]); fq[2] = F[(15) * 64]; __builtin_amdgcn_sched_barrier(0);
        o[1] = MFMA32(fq[3], sbc, o[1]); fq[3] = F[(31) * 64]; __builtin_amdgcn_sched_barrier(0); asm volatile("" : "+v"(vn[1]), "+v"(o[1]));
        sbc = pack8<1>(S[3]);
        vn[0] = MFMA32(fq[0], sbc, vn[0]); fq[0] = F[(32) * 64]; __builtin_amdgcn_sched_barrier(0);
        o[0] = MFMA32(fq[1], sbc, o[0]); fq[1] = F[(34) * 64]; __builtin_amdgcn_sched_barrier(0); asm volatile("" : "+v"(vn[0]), "+v"(o[0]));
        vn[1] = MFMA32(fq[2], sbc, vn[1]); fq[2] = F[(38) * 64]; __builtin_amdgcn_sched_barrier(0);
        o[1] = MFMA32(fq[3], sbc, o[1]); fq[3] = F[(42) * 64]; __builtin_amdgcn_sched_barrier(0); asm volatile("" : "+v"(vn[1]), "+v"(o[1]));
        vb[0] = pack8<0>(vn[0]); vb[1] = pack8<1>(vn[0]); vb[2] = pack8<0>(vn[1]); vb[3] = pack8<1>(vn[1]);
#pragma unroll
        for (int kt = 0; kt < 4; ++kt) S[kt] = S[kt] * al;
        __builtin_amdgcn_sched_barrier(0);
        o[0] = MFMA32(fq[0], vb[0], o[0]); fq[0] = F[(46) * 64]; __builtin_amdgcn_sched_barrier(0);
        o[1] = MFMA32(fq[1], vb[0], o[1]); fq[1] = F[(50) * 64]; __builtin_amdgcn_sched_barrier(0);
        S[0] = MFMA32(fq[2], vb[0], S[0]); fq[2] = F[(33) * 64]; __builtin_amdgcn_sched_barrier(0);
        S[1] = MFMA32(fq[3], vb[0], S[1]); fq[3] = F[(35) * 64]; __builtin_amdgcn_sched_barrier(0);
        S[2] = MFMA32(fq[0], vb[0], S[2]); fq[0] = F[(39) * 64]; __builtin_amdgcn_sched_barrier(0);
        S[3] = MFMA32(fq[1], vb[0], S[3]); fq[1] = F[(43) * 64]; __builtin_amdgcn_sched_barrier(0);
        o[0] = MFMA32(fq[2], vb[1], o[0]); fq[2] = F[(47) * 64]; __builtin_amdgcn_sched_barrier(0);
        o[1] = MFMA32(fq[3], vb[1], o[1]); fq[3] = F[(51) * 64]; __builtin_amdgcn_sched_barrier(0);
        S[0] = MFMA32(fq[0], vb[1], S[0]); fq[0] = F[(36) * 64]; __builtin_amdgcn_sched_barrier(0);
        S[1] = MFMA32(fq[1], vb[1], S[1]); fq[1] = F[(40) * 64]; __builtin_amdgcn_sched_barrier(0);
        S[2] = MFMA32(fq[2], vb[1], S[2]); fq[2] = F[(44) * 64]; __builtin_amdgcn_sched_barrier(0);
        S[3] = MFMA32(fq[3], vb[1], S[3]); fq[3] = F[(48) * 64]; __builtin_amdgcn_sched_barrier(0);
        o[1] = MFMA32(fq[0], vb[2], o[1]); fq[0] = F[(52) * 64]; __builtin_amdgcn_sched_barrier(0);
        S[0] = MFMA32(fq[1], vb[2], S[0]); fq[1] = F[(37) * 64]; __builtin_amdgcn_sched_barrier(0);
        S[1] = MFMA32(fq[2], vb[2], S[1]); fq[2] = F[(41) * 64]; __builtin_amdgcn_sched_barrier(0);
        S[2] = MFMA32(fq[3], vb[2], S[2]); fq[3] = F[(45) * 64]; __builtin_amdgcn_sched_barrier(0);
        S[3] = MFMA32(fq[0], vb[2], S[3]); fq[0] = F[(49) * 64]; __builtin_amdgcn_sched_barrier(0);
        o[1] = MFMA32(fq[1], vb[3], o[1]); fq[1] = F[(53) * 64]; __builtin_amdgcn_sched_barrier(0);
        S[0] = MFMA32(fq[2], vb[3], S[0]); __builtin_amdgcn_sched_barrier(0);
        S[1] = MFMA32(fq[3], vb[3], S[1]); __builtin_amdgcn_sched_barrier(0);
        S[2] = MFMA32(fq[0], vb[3], S[2]); __builtin_amdgcn_sched_barrier(0);
        S[3] = MFMA32(fq[1], vb[3], S[3]); __builtin_amdgcn_sched_barrier(0);
        asm volatile("s_waitcnt lgkmcnt(0)" ::: "memory");
        G2_BAR();
#pragma unroll
        for (int ct = 0; ct < 2; ++ct)
#pragma unroll
            for (int r = 0; r < 16; ++r) ost[(32 * ct + crow(r, hi)) * G2_OLD + vt * 32 + l31] = (bf16_t)(cvtpk(o[ct][r], 0.f) & 0xffffu);
        asm volatile("s_waitcnt lgkmcnt(0)" ::: "memory");
    }
    G2_BAR();
#pragma unroll
    for (int kt = 0; kt < 4; ++kt)
#pragma unroll
        for (int r = 0; r < 16; ++r) Sout[(size_t)(32 * kt + crow(r, hi)) * HD + vt * 32 + l31] = S[kt][r];
#undef G2_BAR
#undef G2_DMA
}

#ifndef PHASE_MASK
#define PHASE_MASK 0xfff
#endif
#define PH(k) (((PHASE_MASK) >> (k)) & 1)
#ifndef DUP_MASK
#define DUP_MASK 0
#endif
#define REP(k) for (int rep_ = 0; rep_ < ((((DUP_MASK) >> (k)) & 1) + 1); ++rep_)
__global__ void __launch_bounds__(NWAVES * 64, 2) hymba_fwd(Args args) {
    extern __shared__ __attribute__((aligned(16))) unsigned char lds_raw[];
    LAS unsigned char* lds = (LAS unsigned char*)lds_raw;
    volatile LAS unsigned* MISC = (volatile LAS unsigned*)(lds + MISC_OFF);
    const int wave = __builtin_amdgcn_readfirstlane((int)threadIdx.x >> 6);
    const int G = gridDim.x, bx = blockIdx.x;
    const int vcu = (G % 8 == 0) ? (bx % 8) * (G / 8) + bx / 8 : bx;
    const int gw = vcu * NWAVES + wave, NGW = G * NWAVES;
    typedef const __attribute__((address_space(4))) Args* KArgs;
#define KARGS() ({ KArgs _p = (KArgs)__builtin_amdgcn_kernarg_segment_ptr(); asm volatile("" : "+s"(_p)); _p; })
#define WSP(T, off) ((T*)(ap->ws + (off)))
#define CF(off) ((float*)(ap->ws + WS_CTL + (off)))
#define x_prompt (ap->in[0])
#define x_sample (ap->in[1])
#define state_pool (ap->in[2])
#define state_conv (ap->in[3])
#define state_delta (ap->in[4])
#define p_prompt (ap->in[5])
#define p_sample (ap->in[6])
#define w_in (ap->in[7])
#define w_pool (ap->in[8])
#define pool_scale (ap->in[9])
#define w_conv (ap->in[10])
#define a_log (ap->in[11])
#define dt_bias (ap->in[12])
#define o_norm_g (ap->in[13])
#define w_out (ap->in[14])
#define ln1_g (ap->in[15])
#define ln1_b (ap->in[16])
#define w_gate_up (ap->in[17])
#define w_down (ap->in[18])
#define ln2_g (ap->in[19])
#define ln2_b (ap->in[20])
#define w_ple_gate (ap->in[21])
#define w_ple_proj (ap->in[22])
#define out (ap->out)
#define WIN WSP(bf16_t, WS_WIN)
#define WOUT WSP(bf16_t, WS_WOUT)
#define WGU WSP(bf16_t, WS_WGU)
#define WDN WSP(bf16_t, WS_WDN)
#define WPG WSP(bf16_t, WS_WPG)
#define WPP WSP(bf16_t, WS_WPP)
#define WPOOL WSP(bf16_t, WS_WPOOL)
#define XB WSP(bf16_t, WS_XB)
#define PB WSP(bf16_t, WS_PB)
#define PROJ WSP(bf16_t, WS_PROJ)
#define BA WSP(float, WS_BA)
#define DPOOL WSP(bf16_t, WS_DPOOL)
#define MIXED WSP(bf16_t, WS_MIXED)
#define QN WSP(bf16_t, WS_QN)
#define KN WSP(bf16_t, WS_KN)
#define VC WSP(bf16_t, WS_VC)
#define GLp WSP(float, WS_GL)
#define GLASTp WSP(float, WS_GLAST)
#define G1O WSP(unsigned char, WS_G1)
#define SLAB WSP(float, WS_SLAB)
#define SLAB2 WSP(float, WS_G1)
#define CPART WSP(float, WS_CPART)
#define PST WSP(float, WS_PST)
#define GAp WSP(float, WS_GA)
#define GBp WSP(float, WS_GB)
#define OB WSP(float, WS_O)
#define HF WSP(float, WS_H)
#define HB WSP(bf16_t, WS_HB)
#define EB WSP(bf16_t, WS_E)
#define ACT WSP(bf16_t, WS_ACT)
#define H2B WSP(bf16_t, WS_H2B)
#define H2B8 WSP(unsigned char, WS_H2B8)
#define HB8I WSP(unsigned char, WS_H2B8)
    unsigned* ctl = (unsigned*)(args.ws + WS_CTL);

    for (int u = threadIdx.x; u < (LDS_BYTES - LDSCTL_OFF) / 4; u += NWAVES * 64) ((LAS unsigned*)(lds + LDSCTL_OFF))[u] = 0u;
    __syncthreads();
    XcdBarrier bar = xcd_barrier_post(ctl + CW_BAR, MISC + 8);

    REP(0) if (PH(0))
    {
        KArgs ap = KARGS();
        int lane_ = lane_id(); asm volatile("" : "+v"(lane_)); const int lane = lane_, tid = wave * 64 + lane; (void)tid;
        LAS float* scr = (LAS float*)(lds + wave * 16384);
        constexpr int I_IN = (DM / 64) * ((PROJ_OUT + 31) / 32), I_SQ = (DM / 64) * (DM / 32), I_GU = (DM / 64) * (2 * DFF / 32), I_DN = (DFF / 64) * (DM / 32),
                      I_PP = (PLE / 64) * (DM / 32), I_PL = 4 * (256 / 64) * (256 / 32);
        constexpr int NITEMS = I_IN + 2 * I_SQ + I_GU + I_DN + I_PP + I_PL;
        for (int it = gw; it < NITEMS; it += NGW) {
            int r = it;
            if (r < I_IN) { transpose_item<0>(w_in, DM, PROJ_OUT, WIN, scr, r, lane); continue; } r -= I_IN;
            if (r < I_SQ) { transpose_item<0>(w_out, DM, DM, WOUT, scr, r, lane); continue; } r -= I_SQ;
            if (r < I_SQ) { transpose_item<0, 1, 64>(w_ple_gate, DM, DM, WPG, scr, r, lane, ln2_g, ln2_b, CPART + 2 * DFF, CPART + (size_t)64 * CP_N + 2 * DFF); continue; } r -= I_SQ;
            if (r < I_GU) { transpose_item<1, 1, 0, 1>(w_gate_up, DM, 2 * DFF, WGU, scr, r, lane, ln1_g, ln1_b, CPART, CPART + (size_t)64 * CP_N); continue; } r -= I_GU;
            if (r < I_DN) { transpose_item<0, 0, WDN8_SCALE>(w_down, DFF, DM, WDN, scr, r, lane); continue; } r -= I_DN;
            if (r < I_PP) { transpose_item<0>(w_ple_proj, PLE, DM, WPP, scr, r, lane); continue; } r -= I_PP;
            { const int grp = r / 32; transpose_item<0>(w_pool + (size_t)grp * 65536, 256, 256, WPOOL + (size_t)grp * 65536, scr, r % 32, lane); }
        }
        { u32x4* z = (u32x4*)(WIN + (size_t)13376 * DM); const int n16 = (PROJ_PAD - 13376) * DM * 2 / 16;
          for (int i = bx * 512 + tid; i < n16; i += G * 512) z[i] = (u32x4){0u, 0u, 0u, 0u}; }
        for (int m = gw; m < M; m += NGW) {
            const f32x4* src = (const f32x4*)(m < MP ? x_prompt + (size_t)m * DM : x_sample + (size_t)(m - MP) * DM) + lane;
            u32x2* dst = (u32x2*)(XB + (size_t)m * DM) + lane;
#pragma unroll
            for (int j = 0; j < 16; ++j) { const f32x4 v = src[64 * j]; u32x2 w; w.x = pk2(v.x, v.y); w.y = pk2(v.z, v.w); dst[64 * j] = w; }
        }
        for (int m = gw; m < M; m += NGW) {
            const f32x4 v = ((const f32x4*)(m < MP ? p_prompt + (size_t)m * PLE : p_sample + (size_t)(m - MP) * PLE))[lane];
            u32x2 w; w.x = pk2(v.x, v.y); w.y = pk2(v.z, v.w); ((u32x2*)(PB + (size_t)m * PLE))[lane] = w;
        }
        for (int i = bx * 512 + tid; i < DB * 7 * (PW / 4); i += G * 512) {
            const int c4 = i % (PW / 4), r = (i / (PW / 4)) % 7, b = i / (7 * (PW / 4));
            ((f32x4*)(out + OUT_NPS + ((size_t)(b * 15 + r)) * PW))[c4] = ((const f32x4*)(state_pool + ((size_t)(b * 15 + 8 + r)) * PW))[c4];
        }
    }
    xcd_barrier(bar);

    REP(1) if (PH(1))
    {
        KArgs ap = KARGS();
        int lane_ = lane_id(); asm volatile("" : "+v"(lane_)); const int lane = lane_, tid = wave * 64 + lane; (void)tid;
        pg8::Gemm g{XB, WIN, M, PROJ_PAD, DM, DM, DM, 0}; pg8::StaticOrder S; S.init(M, PROJ_PAD, DM, G, bx);
        pg8::EpiProj E{PROJ, BA, out};
        pg8::gemm_phase<pg8::EpiProj>(lds, g, S, E, wave);
        if (G == 256 && bx >= 116) { pg8::Gemm g2{PB, WPP, M, DM, PLE, PLE, PLE, 0}; pg8::StaticOrder S2; S2.init(M, DM, PLE, 140, bx - 116);
            pg8::EpiBf16S E2{EB, DM, nullptr};
            pg8::gemm_phase<pg8::EpiBf16S>(lds, g2, S2, E2, wave); }
    }
    xcd_barrier(bar);

    REP(2) if (PH(2))
    {
        KArgs ap = KARGS();
        int lane_ = lane_id(); asm volatile("" : "+v"(lane_)); const int lane = lane_, tid = wave * 64 + lane; (void)tid;
        unsigned wf0 = 0u, wf1 = 0u, wf2 = 0u;
        if (vcu < NB * NH * 32) { const int bh0 = vcu >> 5; const unsigned* pp = (const unsigned*)(PROJ + (size_t)((bh0 / NH) * SEQ + (vcu & 31) * 64 + (tid >> 3)) * PROJ_LD + O1 + (bh0 % NH) * HD + (tid & 7) * 16);
            wf0 = pp[0]; wf1 = pp[DNW / 2]; wf2 = pp[DNW]; }
        for (int it = bx * 512 + tid; it < (M / 8) * 128; it += G * 512) {
            const int blk = it >> 7, cg = it & 127, grp = cg >> 5, w = 2 << grp;
            const int row0 = blk * 8; const bool sample = row0 >= MP;
            const int b = sample ? (row0 - MP) >> 3 : row0 >> 11, t0 = sample ? 0 : (row0 & 2047);
            u32x4 xb[8]; u32x4 hb[15]; f32x4 hs0[15], hs1[15];
#pragma unroll
            for (int r = 0; r < 8; ++r) xb[r] = *(const u32x4*)(PROJ + (size_t)(row0 + r) * PROJ_LD + cg * 8);
#pragma unroll
            for (int j = 1; j <= 15; ++j) {
                hb[j - 1] = (u32x4){0u, 0u, 0u, 0u}; hs0[j - 1] = (f32x4){0.f, 0.f, 0.f, 0.f}; hs1[j - 1] = hs0[j - 1];
                if (j < w) {
                    if (sample) { const float* sp = state_pool + ((size_t)(b * 15 + 15 - j)) * PW + cg * 8; hs0[j - 1] = *(const f32x4*)sp; hs1[j - 1] = *(const f32x4*)(sp + 4); }
                    else if (t0 - j >= 0) hb[j - 1] = *(const u32x4*)(PROJ + (size_t)(row0 - j) * PROJ_LD + cg * 8);
                }
            }
            float x[8][8], hl[15][8];
#pragma unroll
            for (int r = 0; r < 8; ++r) bf8_to_f32(xb[r], x[r]);
#pragma unroll
            for (int j = 0; j < 15; ++j) { bf8_to_f32(hb[j], hl[j]);
#pragma unroll
                for (int e = 0; e < 4; ++e) { hl[j][e] += hs0[j][e]; hl[j][4 + e] += hs1[j][e]; } }
#pragma unroll
            for (int r = 0; r < 8; ++r) {
                float sm[8];
#pragma unroll
                for (int e = 0; e < 8; ++e) sm[e] = x[r][e];
#pragma unroll
                for (int j = 1; j <= 15; ++j) if (j < w) {
#pragma unroll
                    for (int e = 0; e < 8; ++e) sm[e] += (r - j >= 0) ? x[(r - j >= 0) ? r - j : 0][e] : hl[(j - r - 1 >= 0) ? j - r - 1 : 0][e]; }
                const int t = t0 + r; const float cnt = sample ? (float)w : (float)((t + 1) < w ? (t + 1) : w); const float inv = 1.0f / cnt;
                u32x4 o; o.x = pk2(sm[0] * inv - x[r][0], sm[1] * inv - x[r][1]); o.y = pk2(sm[2] * inv - x[r][2], sm[3] * inv - x[r][3]);
                o.z = pk2(sm[4] * inv - x[r][4], sm[5] * inv - x[r][5]); o.w = pk2(sm[6] * inv - x[r][6], sm[7] * inv - x[r][7]);
                *(u32x4*)(DPOOL + (size_t)(row0 + r) * PW + cg * 8) = o;
            }
        }
        for (int n = G * 512 - 1 - (bx * 512 + tid); n < 2 * CP_N; n += G * 512) { const int which = n / CP_N, col = n % CP_N; const float* p = CPART + (size_t)which * 64 * CP_N + col;
            float pv[64];
#pragma unroll
            for (int kb = 0; kb < 64; ++kb) pv[kb] = p[(size_t)kb * CP_N];
            float a = 0.f;
#pragma unroll
            for (int kb = 0; kb < 64; ++kb) a += pv[kb];
            float* dst = col < 2 * DFF ? CF(which ? CTL_C2GU : CTL_C1GU) + col : CF(which ? CTL_C2PG : CTL_C1PG) + (col - 2 * DFF);
            *dst = a; }
        asm volatile("" :: "v"(wf0), "v"(wf1), "v"(wf2));
#pragma unroll 1
        for (int ci = vcu; ci < NB * NH * 32; ci += G) {
            const int bh = ci >> 5, n = ci & 31, b = bh / NH, h = bh % NH;
            const int cin = ci + G, bhn = cin >> 5, hn_ = bhn % NH, r0n_ = cin < NB * NH * 32 ? (bhn / NH) * SEQ + (cin & 31) * 64 : -1;
            g1_chunk(PROJ, w_conv, BA, a_log, dt_bias, G1O + (size_t)ci * G1_CHUNK_BYTES, GLASTp + ci, b * SEQ + n * 64, n * 64, h, lds, wave, lane, r0n_, hn_);
        }
    }
    xcd_barrier(bar);

    REP(11) if (PH(11))
    {
        KArgs ap = KARGS();
        int lane_ = lane_id(); asm volatile("" : "+v"(lane_)); const int lane = lane_;
        if (vcu < NB * NH) {
            g2_wg(G1O, GLASTp, PROJ, o_norm_g, MIXED, out + OUT_NDP + (size_t)vcu * HD * HD, vcu, lds, wave, lane);
        } else {
            const int gsub = G - NB * NH, csub = vcu - NB * NH;
            const int n3 = ((DB * NH) % (gsub * NWAVES)) / NWAVES, gpool = (n3 > 0 && gsub - n3 >= 64) ? gsub - n3 : gsub, cpool = (gpool == gsub) ? csub : csub - n3;
            if (cpool >= 0) { pg8::Gemm g{DPOOL, WPOOL, M, PW, 256, PW, 256, 256}; pg8::StaticOrder S; S.init(M, PW, 256, gpool, cpool);
              pg8::EpiBf16S E{MIXED, DM, pool_scale};
              pg8::gemm_phase<pg8::EpiBf16S>(lds, g, S, E, wave); }
            if (G != 256) { pg8::Gemm g{PB, WPP, M, DM, PLE, PLE, PLE, 0}; pg8::StaticOrder S; S.init(M, DM, PLE, gsub, csub);
              pg8::EpiBf16S E{EB, DM, nullptr};
              pg8::gemm_phase<pg8::EpiBf16S>(lds, g, S, E, wave); }
            LAS unsigned char* wl = lds + wave * SL_BYTES;
            const int nscan = NB * NH;
            const int myidx = (vcu - nscan) * 8 + wave;
            const int nshort = (G - nscan) * NWAVES;
            for (int it = myidx; it < DB * NH; it += nshort) {
                const int b = it / NH, h = it % NH;
                sample_task(w_conv, state_conv, b, BA, a_log, dt_bias, state_delta + (size_t)it * HD * HD, out + OUT_NDS + (size_t)it * HD * HD, PROJ, o_norm_g, MIXED, MP + b * DS, h, wl, lane);
            }
        }
    }
    xcd_barrier(bar);

    REP(5) if (PH(5))
    {
        KArgs ap = KARGS();
        int lane_ = lane_id(); asm volatile("" : "+v"(lane_)); const int lane = lane_, tid = wave * 64 + lane; (void)tid;
        pg8::Gemm g{MIXED, WOUT, M, DM, DM, DM, DM, 0}; pg8::SplitOrder S; S.init(DM, DM, G, bx);
        pg8::EpiLNRes<0> E{nullptr, XB, HB, PST, SLAB, nullptr, nullptr, nullptr, HB8I};
        pg8::gemm_phase<pg8::EpiLNRes<0>, pg8::SplitOrder>(lds, g, S, E, wave);
    }
    xcd_barrier(bar);

    REP(7) if (PH(7))
    {
        KArgs ap = KARGS();
        int lane_ = lane_id(); asm volatile("" : "+v"(lane_)); const int lane = lane_, tid = wave * 64 + lane; (void)tid;
        rows_pass<0>(x_sample, SLAB, out + OUT_Y, HB, PST, CF(CTL_ST1), nullptr, nullptr, nullptr, (unsigned*)(ap->ws) + CW_ROWS1, vcu, G, wave, lane, HB8I);
        pg8::Gemm g{(const bf16_t*)HB8I, WGU, M, 2 * DFF, DM / 2, DM / 2, DM / 2, 0, (const unsigned*)(ap->ws) + CW_ROWS1, (unsigned)G, true}; pg8::GUOrder S; S.init(G, bx, DM / 2);
        pg8::EpiSwiGLULN E{ACT, CF(CTL_ST1), CF(CTL_C1GU), CF(CTL_C2GU), SLAB2, GU8I_SCALE};
        pg8::gemm_phase<pg8::EpiSwiGLULN, pg8::GUOrder, true, 2>(lds, g, S, E, wave);
    }
    xcd_barrier(bar);

    REP(8) if (PH(8))
    {
        KArgs ap = KARGS();
        int lane_ = lane_id(); asm volatile("" : "+v"(lane_)); const int lane = lane_, tid = wave * 64 + lane; (void)tid;
        if (G == 256 && bx < pg8::GU_LEFT * 8) {
            const int t = bx % pg8::GU_LEFT, j = bx / pg8::GU_LEFT, sel = wave;
            const f32x4* sp = (const f32x4*)SLAB2 + ((size_t)(t * 8) * 8 + j) * 32 * 64 + lane;
            f32x4 val[2][2];
#pragma unroll
            for (int bj = 0; bj < 2; ++bj)
#pragma unroll
                for (int n = 0; n < 2; ++n) { const int q = (((sel >> 2) * 2 + bj) * 4 + (sel & 3)) * 2 + n; f32x4 a = sp[q * 64];
#pragma unroll
                    for (int sl = 1; sl < 8; ++sl) a += sp[(size_t)sl * 8 * 32 * 64 + q * 64];
                    val[bj][n] = a; }
            pg8::f32x4_acc_t acc;
#pragma unroll
            for (int ai = 0; ai < 2; ++ai)
#pragma unroll
                for (int bj = 0; bj < 2; ++bj)
#pragma unroll
                    for (int m = 0; m < 4; ++m)
#pragma unroll
                        for (int n = 0; n < 2; ++n) acc.v[ai][bj][m][n] = (ai * 4 + m == sel) ? val[bj][n] : (f32x4){0.f, 0.f, 0.f, 0.f};
            pg8::Unit u{35, pg8::GU_LEFT_PN0 + t, 0, DM / 64, -1, 0};
            pg8::EpiSwiGLULN E{ACT, CF(CTL_ST1), CF(CTL_C1GU), CF(CTL_C2GU), nullptr, 0.f, sel, true};
            E(acc.v, u, j >> 2, j & 3, lane & 15, lane >> 4);
            asm volatile("s_waitcnt vmcnt(0)" ::: "memory"); __syncthreads();
            if (wave == 0 && lane == 0) __hip_atomic_fetch_add((unsigned*)(ap->ws) + 9200, 1u, __ATOMIC_RELAXED, __HIP_MEMORY_SCOPE_AGENT);
        }
        pg8::Gemm g{ACT, WDN, M, DM, DFF / 2, DFF / 2, DFF / 2, 0, (G == 256) ? (const unsigned*)(ap->ws) + 9200 : nullptr, (unsigned)(pg8::GU_LEFT * 8)}; pg8::SplitOrder S; S.init(DM, DFF / 2, G, bx);
        pg8::EpiLNRes<1> E{nullptr, HB, H2B, PST, SLAB, CF(CTL_ST1), ln1_g, ln1_b, H2B8, DN8_INV};
        pg8::gemm_phase<pg8::EpiLNRes<1>, pg8::SplitOrder, true, true>(lds, g, S, E, wave);
    }
    xcd_barrier(bar);

    REP(10) if (PH(10))
    {
        KArgs ap = KARGS();
        int lane_ = lane_id(); asm volatile("" : "+v"(lane_)); const int lane = lane_, tid = wave * 64 + lane; (void)tid;
        rows_pass<1>(nullptr, SLAB, out + OUT_Y, H2B, PST, CF(CTL_ST2), CF(CTL_ST1), ln1_g, ln1_b, (unsigned*)(ap->ws) + CW_ROWS2, vcu, G, wave, lane, H2B8, DN8_INV);
        pg8::Gemm g{(const bf16_t*)H2B8, WPG, M, DM, DM / 2, DM / 2, DM / 2, 0, (const unsigned*)(ap->ws) + CW_ROWS2, (unsigned)G, true}; pg8::SplitOrder S; S.init(DM, DM / 2, G, bx);
        pg8::EpiFinalLN E{out + OUT_Y, H2B, EB, SLAB, CF(CTL_ST2), CF(CTL_C1PG), CF(CTL_C2PG), ln2_g, ln2_b};
        pg8::gemm_phase<pg8::EpiFinalLN, pg8::SplitOrder, true, true>(lds, g, S, E, wave);
    }
    xcd_barrier(bar);
    {
        KArgs ap = KARGS();
        int lane_ = lane_id(); asm volatile("" : "+v"(lane_)); const int tid = wave * 64 + lane_;
        const u32x2* p0 = (const u32x2*)SLAB; const size_t sl = (size_t)MS * DM / 4;
        f32x4* Y = (f32x4*)(out + OUT_Y + (size_t)MP * DM); const u32x2* Eb = (const u32x2*)(EB + (size_t)MP * DM);
        const float* ST2 = CF(CTL_ST2); const f32x4* c1 = (const f32x4*)CF(CTL_C1PG); const f32x4* c2 = (const f32x4*)CF(CTL_C2PG); const f32x4* g2 = (const f32x4*)ln2_g; const f32x4* b2 = (const f32x4*)ln2_b;
        for (int i = bx * 512 + tid; i < MS * DM / 4; i += G * 512) {
            const int row = MP + i / (DM / 4), c4 = i % (DM / 4); float mu, rs; pg8::row_mu_rstd(ST2, row, mu, rs);
            const u32x2 q0 = p0[i], q1 = p0[i + sl], q2 = p0[i + 2 * sl], q3 = p0[i + 3 * sl];
            const f32x4 ps = ((f32x4){bf_lo(q0.x), bf_hi(q0.x), bf_lo(q0.y), bf_hi(q0.y)} + (f32x4){bf_lo(q1.x), bf_hi(q1.x), bf_lo(q1.y), bf_hi(q1.y)}) + ((f32x4){bf_lo(q2.x), bf_hi(q2.x), bf_lo(q2.y), bf_hi(q2.y)} + (f32x4){bf_lo(q3.x), bf_hi(q3.x), bf_lo(q3.y), bf_hi(q3.y)});
            const f32x4 a = (ps * W8_INV - c1[c4] * mu) * rs + c2[c4];
            const f32x4 h = (Y[i] - mu) * rs * g2[c4] + b2[c4]; const u32x2 ew = Eb[i]; f32x4 y;
            y[0] = h[0] + fast_sigmoid(a[0]) * bf_lo(ew.x); y[1] = h[1] + fast_sigmoid(a[1]) * bf_hi(ew.x); y[2] = h[2] + fast_sigmoid(a[2]) * bf_lo(ew.y); y[3] = h[3] + fast_sigmoid(a[3]) * bf_hi(ew.y);
            Y[i] = y;
        }
    }
}

#undef x_prompt
#undef x_sample
#undef state_pool
#undef state_conv
#undef state_delta
#undef p_prompt
#undef p_sample
#undef w_in
#undef w_pool
#undef pool_scale
#undef w_conv
#undef a_log
#undef dt_bias
#undef o_norm_g
#undef w_out
#undef ln1_g
#undef ln1_b
#undef w_gate_up
#undef w_down
#undef ln2_g
#undef ln2_b
#undef w_ple_gate
#undef w_ple_proj
#undef out
#undef WIN
#undef WOUT
#undef WGU
#undef WDN
#undef WPG
#undef WPP
#undef WPOOL
#undef XB
#undef PB
#undef PROJ
#undef BA
#undef DPOOL
#undef MIXED
#undef GLp
#undef GLASTp
#undef G1O
#undef SLAB
#undef SLAB2
#undef CPART
#undef PST
#undef CF
#undef QN
#undef KN
#undef VC
#undef GAp
#undef GBp
#undef OB
#undef HF
#undef HB
#undef EB
#undef ACT
#undef H2B
#undef H2B8
#undef HB8I
extern "C" void kernel_launch(void* const* d_in, const int* in_sizes, int n_in, void* d_out, int out_size, void* d_ws, size_t ws_size, hipStream_t stream) {
    static int grid = 0;
    if (grid == 0) {
        if (n_in != 23 || (size_t)out_size != OUT_END || ws_size < WS_END) {
            fprintf(stderr, "kernel_launch: unexpected shapes: n_in %d out %d ws %zu (need %zu)\n", n_in, out_size, ws_size, (size_t)WS_END); grid = -1;
        } else {
            int dev = 0, cus = 0;
            if (hipGetDevice(&dev) != hipSuccess || hipDeviceGetAttribute(&cus, hipDeviceAttributeMultiprocessorCount, dev) != hipSuccess) { grid = -1; }
            else if (hipFuncSetAttribute((const void*)hymba_fwd, hipFuncAttributeMaxDynamicSharedMemorySize, LDS_BYTES) != hipSuccess) { fprintf(stderr, "kernel_launch: hipFuncSetAttribute failed\n"); grid = -1; }
            else { int per_cu = 0; (void)hipOccupancyMaxActiveBlocksPerMultiprocessor(&per_cu, (const void*)hymba_fwd, NWAVES * 64, LDS_BYTES); (void)hipGetLastError(); grid = cus; }
        }
    }
    if (grid < 0) { (void)hipMemsetAsync(d_out, 0, (size_t)out_size * 4, stream); return; }
    (void)hipMemsetAsync((char*)d_ws + WS_CTL, 0, CTL_ZERO_BYTES, stream);
    Args a{};
    for (int i = 0; i < 23; ++i) a.in[i] = (const float*)d_in[i];
    a.out = (float*)d_out; a.ws = (unsigned char*)d_ws;
    hipLaunchKernelGGL(hymba_fwd, dim3(grid), dim3(NWAVES * 64), LDS_BYTES, stream, a);
}
```
